# Optimizing an MI355X kernel written in HIP

```python
import math
import jax, jax.numpy as jnp
from jax import lax
import numpy as np

D_MODEL = 1024
BATCH = 8
SEQ = 2048
DEPTH = 2

RET_HEADS = 4
RET_DK = 256
RET_DV = 512
RET_CHUNK = 128
MLA_HEADS = 8
MLA_NOPE = 128
MLA_ROPE = 64
MLA_V = 128
MLA_Q_RANK = 256
MLA_KV_RANK = 256
ATTN_Q_BLOCK = 128
MOBA_HEADS = 16
MOBA_DH = D_MODEL // MOBA_HEADS
MOBA_BLOCK = 256
MOBA_TOPK = 3
MOBA_Q_CHUNK = 32

ROPE_THETA = 10000.0
LN_EPS = 1e-5
RMS_EPS = 1e-6
NEG = -1e30
DN_ALPHA = (2.0 * DEPTH) ** 0.25
DN_BETA = (8.0 * DEPTH) ** -0.25
N_EVEN = (DEPTH + 1) // 2
N_ODD = DEPTH // 2

RET_W = RET_HEADS * RET_DV
MLA_W = MLA_HEADS * MLA_V
MOBA_W = MOBA_HEADS * MOBA_DH
EVEN_SPLITS = (RET_HEADS * RET_DK, RET_HEADS * RET_DK, RET_W, RET_W,
               MLA_Q_RANK, MLA_KV_RANK, MLA_ROPE, MLA_W)
EVEN_IN = sum(EVEN_SPLITS)
ODD_SPLITS = (MOBA_W, MOBA_W, MOBA_W, MOBA_W)
ODD_IN = sum(ODD_SPLITS)

kernel_name = "hybrid_retention_mla_moba_deepnorm"


def _split(h, sizes):
    offs = np.cumsum(sizes)[:-1].tolist()
    return jnp.split(h, offs, axis=-1)


def _heads(t, n):
    B, S, W = t.shape
    return t.reshape(B, S, n, W // n).transpose(0, 2, 1, 3)


def _merge(t):
    B, H, S, d = t.shape
    return t.transpose(0, 2, 1, 3).reshape(B, S, H * d)


def layer_norm(x, g, b):
    xf = x.astype(jnp.float32)
    mu = jnp.mean(xf, -1, keepdims=True)
    xc = xf - mu
    var = jnp.mean(xc * xc, -1, keepdims=True)
    return (xc * lax.rsqrt(var + LN_EPS) * g + b).astype(x.dtype)


def rms_norm(x, g):
    xf = x.astype(jnp.float32)
    return (xf * lax.rsqrt(jnp.mean(xf * xf, -1, keepdims=True) + RMS_EPS) * g).astype(x.dtype)


def rope(x, pos):
    d = x.shape[-1]
    inv = 1.0 / (ROPE_THETA ** (jnp.arange(0, d, 2, dtype=jnp.float32) / d))
    ang = pos.astype(jnp.float32)[:, None, :, None] * inv
    cos, sin = jnp.cos(ang), jnp.sin(ang)
    x1, x2 = x[..., : d // 2], x[..., d // 2:]
    return jnp.concatenate([x1 * cos - x2 * sin, x1 * sin + x2 * cos], -1).astype(x.dtype)


def retnet_rotate(x, pos):
    d = x.shape[-1]
    inv = 1.0 / (ROPE_THETA ** jnp.linspace(0.0, 1.0, d // 2, dtype=jnp.float32))
    ang = pos.astype(jnp.float32)[:, None, :, None] * inv
    cos, sin = jnp.cos(ang), jnp.sin(ang)
    x1, x2 = x[..., 0::2], x[..., 1::2]
    out = jnp.stack([x1 * cos - x2 * sin, x2 * cos + x1 * sin], -1)
    return out.reshape(x.shape).astype(x.dtype)


def retention_chunkwise(q, k, v):
    B, H, S, dk = q.shape
    dv = v.shape[-1]
    C = RET_CHUNK
    n = S // C
    q = q.astype(jnp.float32)
    k = k.astype(jnp.float32) * (dk ** -0.5)
    v = v.astype(jnp.float32)
    log_g = jnp.log(1.0 - 2.0 ** (-5.0 - jnp.arange(H, dtype=jnp.float32)))
    qc = q.reshape(B, H, n, C, dk)
    kc = k.reshape(B, H, n, C, dk)
    vc = v.reshape(B, H, n, C, dv)
    idx = jnp.arange(C, dtype=jnp.float32)
    rel = idx[:, None] - idx[None, :]
    decay = jnp.where(rel >= 0, jnp.exp(log_g[:, None, None] * jnp.maximum(rel, 0.0)), 0.0)
    inner = jnp.einsum('bhncd,bhnkd->bhnck', qc, kc) * decay[None, :, None]
    o_inner = jnp.einsum('bhnck,bhnkv->bhncv', inner, vc)
    zeta = jnp.exp(log_g[:, None] * (C - 1.0 - idx))
    kv_chunk = jnp.einsum('bhnkd,bhnkv->bhndv', kc * zeta[None, :, None, :, None], vc)
    g_chunk = jnp.exp(log_g * C)[None, :, None, None]

    def step(R, kv):
        return R * g_chunk + kv, R

    _, r_prev = lax.scan(step, jnp.zeros((B, H, dk, dv), jnp.float32), jnp.moveaxis(kv_chunk, 2, 0))
    r_prev = jnp.moveaxis(r_prev, 0, 2)
    xi = jnp.exp(log_g[:, None] * (idx + 1.0))
    o_cross = jnp.einsum('bhncd,bhndv->bhncv', qc, r_prev) * xi[None, :, None, :, None]
    return (o_inner + o_cross).reshape(B, H, S, dv)


def head_group_norm(o):
    of = o.astype(jnp.float32)
    mu = jnp.mean(of, -1, keepdims=True)
    oc = of - mu
    var = jnp.mean(oc * oc, -1, keepdims=True)
    return oc * lax.rsqrt(var + LN_EPS)


def causal_attention(q, k, v, scale):
    B, H, S, d = q.shape
    dv = v.shape[-1]
    nq = S // ATTN_Q_BLOCK
    qb = q.reshape(B, H, nq, ATTN_Q_BLOCK, d).transpose(2, 0, 1, 3, 4)
    kpos = jnp.arange(S)

    def one(args):
        qi, i = args
        s = jnp.einsum('bhqd,bhkd->bhqk', qi, k).astype(jnp.float32) * scale
        qpos = i * ATTN_Q_BLOCK + jnp.arange(ATTN_Q_BLOCK)
        s = jnp.where(kpos[None, :] <= qpos[:, None], s, NEG)
        p = jax.nn.softmax(s, axis=-1).astype(v.dtype)
        return jnp.einsum('bhqk,bhkd->bhqd', p, v)

    out = lax.map(one, (qb, jnp.arange(nq)))
    return out.transpose(1, 2, 0, 3, 4).reshape(B, H, S, dv)


def moba_attention(q, k, v):
    B, H, S, dh = q.shape
    L = MOBA_BLOCK
    nb = -(-S // L)
    pad = nb * L - S
    kp = jnp.pad(k, ((0, 0), (0, 0), (0, pad), (0, 0)))
    vp = jnp.pad(v, ((0, 0), (0, 0), (0, pad), (0, 0)))
    kb = kp.reshape(B, H, nb, L, dh)
    vb = vp.reshape(B, H, nb, L, dh)
    kmean = jnp.mean(kb.astype(jnp.float32), axis=3)
    qblk = jnp.arange(S) // L
    gate = jnp.einsum('bhsd,bhnd->bhsn', q.astype(jnp.float32), kmean)
    past = jnp.arange(nb)[None, :] < qblk[:, None]
    gate = jnp.where(past, gate, NEG)
    k_sel = min(MOBA_TOPK, nb)
    _, sel = lax.top_k(gate, k_sel)
    valid = jnp.arange(k_sel)[None, :] < qblk[:, None]
    scale = dh ** -0.5
    Qc = MOBA_Q_CHUNK
    nc = S // Qc
    qch = jnp.moveaxis(q.reshape(B, H, nc, Qc, dh), 2, 0)
    selch = jnp.moveaxis(sel.reshape(B, H, nc, Qc, k_sel), 2, 0)
    validch = valid.reshape(nc, Qc, k_sel)
    bi = jnp.arange(B)[:, None, None, None]
    hi = jnp.arange(H)[None, :, None, None]

    def one(args):
        qi, si, vi, c = args
        q0 = c * Qc
        qpos = q0 + jnp.arange(Qc)
        own = q0 // L
        kg = kb[bi, hi, si]
        vg = vb[bi, hi, si]
        s_g = jnp.einsum('bhqd,bhqnld->bhqnl', qi, kg).astype(jnp.float32) * scale
        s_g = jnp.where(vi[None, None, :, :, None], s_g, NEG)
        ko = lax.dynamic_slice_in_dim(kp, own * L, L, axis=2)
        vo = lax.dynamic_slice_in_dim(vp, own * L, L, axis=2)
        s_o = jnp.einsum('bhqd,bhld->bhql', qi, ko).astype(jnp.float32) * scale
        kpos = own * L + jnp.arange(L)
        s_o = jnp.where(kpos[None, :] <= qpos[:, None], s_o, NEG)
        s = jnp.concatenate([s_g.reshape(B, H, Qc, k_sel * L), s_o], axis=-1)
        p = jax.nn.softmax(s, axis=-1).astype(v.dtype)
        p_g = p[..., : k_sel * L].reshape(B, H, Qc, k_sel, L)
        p_o = p[..., k_sel * L:]
        return (jnp.einsum('bhqnl,bhqnld->bhqd', p_g, vg)
                + jnp.einsum('bhql,bhld->bhqd', p_o, vo))

    out = lax.map(one, (qch, selch, validch, jnp.arange(nc)))
    return jnp.moveaxis(out, 0, 2).reshape(B, H, S, dh)


def retention_mla_layer(x, pos, w_in, q_norm_g, w_uq, kv_norm_g, w_ukv, w_out):
    B, S, _ = x.shape
    h = x @ w_in
    rq, rk, rv, rg, mq, mkv, mkr, mg = _split(h, EVEN_SPLITS)
    q_r = retnet_rotate(_heads(rq, RET_HEADS), pos)
    k_r = retnet_rotate(_heads(rk, RET_HEADS), pos)
    o_r = head_group_norm(retention_chunkwise(q_r, k_r, _heads(rv, RET_HEADS)))
    ret_out = (_merge(o_r) * jax.nn.silu(rg.astype(jnp.float32))).astype(x.dtype)
    q_m = (rms_norm(mq, q_norm_g) @ w_uq).reshape(B, S, MLA_HEADS, MLA_NOPE + MLA_ROPE).transpose(0, 2, 1, 3)
    q_nope, q_pe = q_m[..., :MLA_NOPE], rope(q_m[..., MLA_NOPE:], pos)
    kv = (rms_norm(mkv, kv_norm_g) @ w_ukv).reshape(B, S, MLA_HEADS, MLA_NOPE + MLA_V).transpose(0, 2, 1, 3)
    k_nope, v_m = kv[..., :MLA_NOPE], kv[..., MLA_NOPE:]
    k_pe = rope(mkr[:, None], pos)
    q_full = jnp.concatenate([q_nope, q_pe], -1)
    k_full = jnp.concatenate([k_nope, jnp.broadcast_to(k_pe, (B, MLA_HEADS, S, MLA_ROPE))], -1)
    o_m = causal_attention(q_full, k_full, v_m, (MLA_NOPE + MLA_ROPE) ** -0.5)
    mla_out = (_merge(o_m) * jax.nn.silu(mg)).astype(x.dtype)
    return jnp.concatenate([ret_out, mla_out], axis=-1) @ w_out


def moba_layer(x, pos, w_in, w_out):
    h = x @ w_in
    q, k, v, g = _split(h, ODD_SPLITS)
    q = rope(_heads(q, MOBA_HEADS), pos)
    k = rope(_heads(k, MOBA_HEADS), pos)
    o = moba_attention(q, k, _heads(v, MOBA_HEADS))
    return (_merge(o) * jax.nn.silu(g)) @ w_out


def setup_inputs(seed: int = 0) -> dict:
    key = jax.random.key(seed)
    ks = jax.random.split(key, 16)
    f32 = jnp.float32
    nrm = lambda k, shape, fan_in, gain=1.0: jax.random.normal(k, shape, f32) * (gain * fan_in ** -0.5)
    x = jax.random.normal(ks[0], (BATCH, SEQ, D_MODEL), f32)
    offs = jax.random.randint(ks[1], (BATCH, 1), 0, 1024, dtype=jnp.int32)
    positions = (offs + jnp.arange(SEQ, dtype=jnp.int32)[None, :]).astype(jnp.int32)
    return {
        "x": x,
        "positions": positions,
        "w_in_even": nrm(ks[2], (N_EVEN, D_MODEL, EVEN_IN), D_MODEL),
        "q_norm_even": 1.0 + 0.02 * jax.random.normal(ks[3], (N_EVEN, MLA_Q_RANK), f32),
        "w_uq_even": nrm(ks[4], (N_EVEN, MLA_Q_RANK, MLA_HEADS * (MLA_NOPE + MLA_ROPE)), MLA_Q_RANK),
        "kv_norm_even": 1.0 + 0.02 * jax.random.normal(ks[5], (N_EVEN, MLA_KV_RANK), f32),
        "w_ukv_even": nrm(ks[6], (N_EVEN, MLA_KV_RANK, MLA_HEADS * (MLA_NOPE + MLA_V)), MLA_KV_RANK),
        "w_out_even": nrm(ks[7], (N_EVEN, RET_W + MLA_W, D_MODEL), RET_W + MLA_W, DN_BETA),
        "w_in_odd": nrm(ks[8], (N_ODD, D_MODEL, ODD_IN), D_MODEL),
        "w_out_odd": nrm(ks[9], (N_ODD, MOBA_W, D_MODEL), MOBA_W, DN_BETA),
        "ln_g": 1.0 + 0.02 * jax.random.normal(ks[10], (DEPTH, D_MODEL), f32),
        "ln_b": 0.02 * jax.random.normal(ks[11], (DEPTH, D_MODEL), f32),
    }


def reference(x, positions, w_in_even, q_norm_even, w_uq_even, kv_norm_even, w_ukv_even,
              w_out_even, w_in_odd, w_out_odd, ln_g, ln_b):
    for i in range(DEPTH):
        j = i // 2
        if i % 2 == 0:
            y = retention_mla_layer(x, positions, w_in_even[j], q_norm_even[j], w_uq_even[j],
                                    kv_norm_even[j], w_ukv_even[j], w_out_even[j])
        else:
            y = moba_layer(x, positions, w_in_odd[j], w_out_odd[j])
        x = layer_norm(DN_ALPHA * x + y, ln_g[i], ln_b[i])
    return x
```

```cpp
#include <hip/hip_runtime.h>
#include <cstdio>
#include <cstdint>

constexpr int NB = 8, SEQ = 2048, DM = 1024, MT = NB * SEQ;
constexpr int N1 = 7936;
constexpr int C_RQ = 0, C_RK = 1024, C_RV = 2048, C_RG = 4096, C_MQ = 6144, C_MKV = 6400, C_MG = 6656, C_MKR = 7680, C_PAD = 7744;
constexpr float LN_EPS = 1e-5f, RMS_EPS = 1e-6f;
constexpr float DN_ALPHA = 1.4142135623730951f;
constexpr float LOG2_THETA = 13.287712379549449f;
constexpr float QS_MLA = 0.10411754627697264f;
constexpr float QS_MOBA = 0.18033688011112042f;

typedef unsigned short bf16_t;
typedef float f32x4 __attribute__((ext_vector_type(4)));
typedef unsigned u32x4 __attribute__((ext_vector_type(4)));
typedef unsigned u32x2 __attribute__((ext_vector_type(2)));

constexpr size_t MiB = 1u << 20;
constexpr size_t WS_CTL = 0;
constexpr size_t WS_W1T = 1 * MiB;
constexpr size_t WS_WUQT = WS_W1T + (size_t)N1 * 1024 * 2;
constexpr size_t WS_WUKVT = WS_WUQT + (size_t)1536 * 256 * 2;
constexpr size_t WS_WO0T = WS_WUKVT + (size_t)2048 * 256 * 2;
constexpr size_t WS_W3T = WS_WO0T + (size_t)1024 * 3072 * 2;
constexpr size_t WS_WO1T = WS_W3T + (size_t)4096 * 1024 * 2;
constexpr size_t WS_WEND = WS_WO1T + (size_t)1024 * 1024 * 2;
static_assert(WS_WEND <= 35 * MiB, "weights");
constexpr size_t WS_SSQQ = 35 * MiB;
constexpr size_t WS_SSQKV = WS_SSQQ + (size_t)MT * 16;
constexpr size_t WS_KPART = WS_SSQKV + (size_t)MT * 16;
constexpr size_t WS_KPE = 36 * MiB;
constexpr size_t WS_R39 = 39 * MiB;
constexpr size_t WS_R71 = 71 * MiB;
constexpr size_t WS_R135 = 135 * MiB;
constexpr size_t WS_R199 = 199 * MiB;
constexpr size_t WS_R231 = 231 * MiB;
constexpr size_t WS_END = 256 * MiB;

struct Params {
    const float* x; const int* pos;
    const float *w_in_e, *qn_g, *w_uq, *kvn_g, *w_ukv, *w_out_e, *w_in_o, *w_out_o, *ln_g, *ln_b;
    float* out; unsigned char* ws;
};
struct Bufs {
    bf16_t *W1t, *Wuqt, *Wukvt, *Wo0t, *W3t, *Wo1t;
    float *SSQQ, *SSQKV, *KPART; bf16_t* KPE;
    bf16_t *XB, *VM, *X1B;
    bf16_t *GR, *QB, *KB; float* Z1;
    bf16_t *VR, *QM, *VB, *GB; float* Z;
    bf16_t *QR, *KN; bf16_t *MQ, *MKV;
    bf16_t *KR, *GM; float* X1;
};
__host__ __device__ inline Bufs make_bufs(const Params& p) {
    Bufs b; unsigned char* w = p.ws;
    b.W1t = (bf16_t*)(w + WS_W1T); b.Wuqt = (bf16_t*)(w + WS_WUQT); b.Wukvt = (bf16_t*)(w + WS_WUKVT); b.Wo0t = (bf16_t*)(w + WS_WO0T); b.W3t = (bf16_t*)(w + WS_W3T); b.Wo1t = (bf16_t*)(w + WS_WO1T);
    b.SSQQ = (float*)(w + WS_SSQQ); b.SSQKV = (float*)(w + WS_SSQKV); b.KPART = (float*)(w + WS_KPART); b.KPE = (bf16_t*)(w + WS_KPE);
    b.XB = (bf16_t*)(w + WS_R39); b.VM = b.XB; b.X1B = b.XB;
    b.GR = (bf16_t*)(w + WS_R71); b.QB = b.GR; b.KB = b.GR + (size_t)MT * 1024; b.Z1 = (float*)(w + WS_R71);
    b.VR = (bf16_t*)(w + WS_R135); b.QM = b.VR; b.Z = (float*)(w + WS_R135); b.VB = b.VR; b.GB = b.VR + (size_t)MT * 1024;
    b.QR = (bf16_t*)(w + WS_R199); b.KN = b.QR;
    b.MQ = (bf16_t*)(w + WS_R231); b.MKV = b.MQ + (size_t)MT * 256;
    b.KR = (bf16_t*)p.out; b.X1 = p.out; b.GM = (bf16_t*)((unsigned char*)p.out + 32 * MiB);
    return b;
}

__device__ __forceinline__ unsigned f2bf(float f) { unsigned u = __builtin_bit_cast(unsigned, f); return (u + 0x7fffu + ((u >> 16) & 1u)) >> 16; }
__device__ __forceinline__ unsigned pk2(float lo, float hi) { return f2bf(lo) | (f2bf(hi) << 16); }
__device__ __forceinline__ float bf2f(bf16_t v) { return __builtin_bit_cast(float, (unsigned)v << 16); }
__device__ __forceinline__ float bflo(unsigned w) { return __builtin_bit_cast(float, w << 16); }
__device__ __forceinline__ float bfhi(unsigned w) { return __builtin_bit_cast(float, w & 0xffff0000u); }
__device__ __forceinline__ float wave_sum(float v) {
#pragma unroll
    for (int o = 1; o < 64; o <<= 1) v += __shfl_xor(v, o);
    return v;
}
__device__ __forceinline__ float silu_f(float x) { return x / (1.0f + __expf(-x)); }
__device__ __forceinline__ void sincos_rev(float ang, float& s, float& c) {
    float r = ang * 0.15915494309189535f; r = r - floorf(r);
    s = __builtin_amdgcn_sinf(r); c = __builtin_amdgcn_cosf(r);
}
__device__ __forceinline__ float gamma_log2(int h) { return h == 0 ? -0.04580368961312479f : h == 1 ? -0.02272007650008353f : h == 2 ? -0.011315313227834146f : -0.005646563141142063f; }
__device__ __forceinline__ void store8bf(bf16_t* p, const float* v) {
    u32x4 w; w.x = pk2(v[0], v[1]); w.y = pk2(v[2], v[3]); w.z = pk2(v[4], v[5]); w.w = pk2(v[6], v[7]); *(u32x4*)p = w;
}
template <bool RETNET> __device__ __forceinline__ void rot4(float* v, float posf, int i0) {
#pragma unroll
    for (int p = 0; p < 4; ++p) {
        const float inv = RETNET ? exp2f(-(LOG2_THETA / 127.0f) * (float)(i0 + p)) : exp2f(-(LOG2_THETA / 32.0f) * (float)(i0 + p));
        float s, c; sincos_rev(posf * inv, s, c);
        const float a = v[2 * p], b = v[2 * p + 1];
        v[2 * p] = a * c - b * s; v[2 * p + 1] = b * c + a * s;
    }
}

__device__ __forceinline__ void epi_inproj_even(const Bufs& B, const int* pos, int row, int col0, float* v) {
    if (col0 < C_RV) {
        const bool isk = col0 >= C_RK; const int c = col0 - (isk ? C_RK : 0), h = c >> 8, i0 = (c & 255) >> 1, ic = row & 127;
        rot4<true>(v, (float)pos[row], i0);
        const float e = (float)(ic + 1) * gamma_log2(h);
        const float sc = isk ? exp2f(-e) * 0.0625f : exp2f(e);
#pragma unroll
        for (int j = 0; j < 8; ++j) v[j] *= sc;
        store8bf((isk ? B.KR : B.QR) + (size_t)row * 1024 + c, v);
    } else if (col0 < C_RG) { store8bf(B.VR + (size_t)row * 2048 + (col0 - C_RV), v);
    } else if (col0 < C_MQ) {
#pragma unroll
        for (int j = 0; j < 8; ++j) v[j] = silu_f(v[j]);
        store8bf(B.GR + (size_t)row * 2048 + (col0 - C_RG), v);
    } else if (col0 < C_MKV) { store8bf(B.MQ + (size_t)row * 256 + (col0 - C_MQ), v);
    } else if (col0 < C_MG) { store8bf(B.MKV + (size_t)row * 256 + (col0 - C_MKV), v);
    } else if (col0 < C_MKR) {
#pragma unroll
        for (int j = 0; j < 8; ++j) v[j] = silu_f(v[j]);
        store8bf(B.GM + (size_t)row * 1024 + (col0 - C_MG), v);
    } else if (col0 < C_PAD) {
        rot4<false>(v, (float)pos[row], (col0 - C_MKR) >> 1);
        store8bf(B.KPE + (size_t)row * 64 + (col0 - C_MKR), v);
    }
}
__device__ __forceinline__ float rstd_from(const float* ssq, int row) {
    const f32x4 s = *(const f32x4*)(ssq + (size_t)row * 4);
    return 1.0f / sqrtf(((s.x + s.y) + (s.z + s.w)) * (1.0f / 256.0f) + RMS_EPS);
}
__device__ __forceinline__ void epi_upq(const Bufs& B, const int* pos, int row, int col0, float* v, float rstd) {
    const int l = col0 % 192;
#pragma unroll
    for (int j = 0; j < 8; ++j) v[j] *= rstd;
    if (l >= 128) rot4<false>(v, (float)pos[row], (l - 128) >> 1);
#pragma unroll
    for (int j = 0; j < 8; ++j) v[j] *= QS_MLA;
    store8bf(B.QM + (size_t)row * 1536 + col0, v);
}
__device__ __forceinline__ void epi_upkv(const Bufs& B, int row, int col0, float* v, float rstd) {
    const int hd = col0 >> 8, l = col0 & 255;
#pragma unroll
    for (int j = 0; j < 8; ++j) v[j] *= rstd;
    if (l < 128) store8bf(B.KN + (size_t)row * 1024 + hd * 128 + l, v);
    else store8bf(B.VM + (size_t)row * 1024 + hd * 128 + (l - 128), v);
}
__device__ __forceinline__ void epi_inproj_odd(const Bufs& B, const int* pos, int row, int col0, float* v) {
    if (col0 < 2048) {
        const bool isk = col0 >= 1024; const int c = col0 & 1023;
        rot4<false>(v, (float)pos[row], (c & 63) >> 1);
        if (!isk) {
#pragma unroll
            for (int j = 0; j < 8; ++j) v[j] *= QS_MOBA;
        }
        store8bf((isk ? B.KB : B.QB) + (size_t)row * 1024 + c, v);
    } else if (col0 < 3072) { store8bf(B.VB + (size_t)row * 1024 + (col0 - 2048), v);
    } else {
#pragma unroll
        for (int j = 0; j < 8; ++j) v[j] = silu_f(v[j]);
        store8bf(B.GB + (size_t)row * 1024 + (col0 - 3072), v);
    }
}

enum { WK_IN_E = 0, WK_UQ, WK_UKV, WK_OUT_E, WK_IN_O, WK_OUT_O };
__device__ __forceinline__ int srccol(int kind, int rho) {
    switch (kind) {
    case WK_IN_E:
        if (rho < C_MG) return rho;
        if (rho < C_MKR) return 6720 + (rho - C_MG);
        if (rho < C_PAD) { const int l = rho - C_MKR; return 6656 + 32 * (l & 1) + (l >> 1); }
        return -1;
    case WK_UQ: { const int hd = rho / 192, l = rho % 192; if (l < 128) return rho; const int lp = l - 128; return hd * 192 + 128 + 32 * (lp & 1) + (lp >> 1); }
    case WK_IN_O: { if (rho >= 2048) return rho; const int l = rho & 63; return (rho & ~63) + 32 * (l & 1) + (l >> 1); }
    default: return rho;
    }
}
__device__ __forceinline__ void transpose_item(const float* W, const float* gain, int kind, int K, int N, bf16_t* WT, float* scr  , int item, int lane) {
    const int nblk_k = K / 64; const int rb = item / nblk_k, kb = item % nblk_k; const int k0 = kb * 64, r0 = rb * 32;
    const int sc = srccol(kind, r0 + (lane & 31));
#pragma unroll 8
    for (int i = 0; i < 32; ++i) { const int kk = 2 * i + (lane >> 5); float val = 0.f; if (sc >= 0) { val = W[(size_t)(k0 + kk) * N + sc]; if (gain) val *= gain[k0 + kk]; } scr[kk * 33 + (lane & 31)] = val; }
    __builtin_amdgcn_s_waitcnt(0xc07f); __builtin_amdgcn_wave_barrier();
    const int c = lane & 7;
#pragma unroll
    for (int j = 0; j < 4; ++j) { const int n = (lane >> 3) + 8 * j; const float* s = scr + (8 * c) * 33 + n;
        u32x4 o; o.x = pk2(s[0 * 33], s[1 * 33]); o.y = pk2(s[2 * 33], s[3 * 33]); o.z = pk2(s[4 * 33], s[5 * 33]); o.w = pk2(s[6 * 33], s[7 * 33]);
        *(u32x4*)(WT + (size_t)(r0 + n) * K + k0 + 8 * c) = o; }
    __builtin_amdgcn_s_waitcnt(0xc07f); __builtin_amdgcn_wave_barrier();
}
constexpr int IT_W1 = (1024 / 64) * (N1 / 32), IT_UQ = (256 / 64) * (1536 / 32), IT_UKV = (256 / 64) * (2048 / 32), IT_O0 = (3072 / 64) * (1024 / 32), IT_W3 = (1024 / 64) * (4096 / 32), IT_O1 = (1024 / 64) * (1024 / 32);
constexpr int IT_ALL = IT_W1 + IT_UQ + IT_UKV + IT_O0 + IT_W3 + IT_O1;
__device__ __forceinline__ void phase_prologue(const Params& p, const Bufs& B, float* lds_f, int gw, int ngw, int wave, int lane) {
    float* scr = lds_f + wave * (64 * 33);
    for (int it = gw; it < IT_ALL; it += ngw) {
        int r = it;
        if (r < IT_W1) { transpose_item(p.w_in_e, nullptr, WK_IN_E, 1024, 7744, B.W1t, scr, r, lane); continue; } r -= IT_W1;
        if (r < IT_UQ) { transpose_item(p.w_uq, p.qn_g, WK_UQ, 256, 1536, B.Wuqt, scr, r, lane); continue; } r -= IT_UQ;
        if (r < IT_UKV) { transpose_item(p.w_ukv, p.kvn_g, WK_UKV, 256, 2048, B.Wukvt, scr, r, lane); continue; } r -= IT_UKV;
        if (r < IT_O0) { transpose_item(p.w_out_e, nullptr, WK_OUT_E, 3072, 1024, B.Wo0t, scr, r, lane); continue; } r -= IT_O0;
        if (r < IT_W3) { transpose_item(p.w_in_o, nullptr, WK_IN_O, 1024, 4096, B.W3t, scr, r, lane); continue; } r -= IT_W3;
        transpose_item(p.w_out_o, nullptr, WK_OUT_O, 1024, 1024, B.Wo1t, scr, r, lane);
    }
    for (int m = gw; m < MT; m += ngw) {
        const f32x4* xr = (const f32x4*)(p.x + (size_t)m * DM) + lane; u32x2* o = (u32x2*)(B.XB + (size_t)m * DM) + lane;
#pragma unroll
        for (int j = 0; j < 4; ++j) { const f32x4 v = xr[64 * j]; u32x2 w; w.x = pk2(v.x, v.y); w.y = pk2(v.z, v.w); o[64 * j] = w; }
    }
}
__global__ __launch_bounds__(512) void k_prologue(Params p) {
    extern __shared__ __attribute__((aligned(16))) unsigned char lds[];
    const Bufs B = make_bufs(p);
    const int wave = threadIdx.x >> 6, lane = threadIdx.x & 63;
    phase_prologue(p, B, (float*)lds, blockIdx.x * 8 + wave, gridDim.x * 8, wave, lane);
}

__device__ __forceinline__ void ln_row(const float* z, const float* g, const float* b, float* of, bf16_t* ob, int lane) {
    const f32x4* zr = (const f32x4*)z + lane; f32x4 v[4]; float s = 0.f;
#pragma unroll
    for (int j = 0; j < 4; ++j) { v[j] = zr[64 * j]; s += (v[j].x + v[j].y) + (v[j].z + v[j].w); }
    const float mean = wave_sum(s) * (1.f / DM); float s2 = 0.f;
#pragma unroll
    for (int j = 0; j < 4; ++j) { v[j] = v[j] - mean; s2 += (v[j].x * v[j].x + v[j].y * v[j].y) + (v[j].z * v[j].z + v[j].w * v[j].w); }
    const float rstd = 1.f / sqrtf(wave_sum(s2) * (1.f / DM) + LN_EPS);
#pragma unroll
    for (int j = 0; j < 4; ++j) { const f32x4 gg = ((const f32x4*)g)[lane + 64 * j], bb = ((const f32x4*)b)[lane + 64 * j]; const f32x4 y = v[j] * rstd * gg + bb;
        ((f32x4*)of)[lane + 64 * j] = y; if (ob) { u32x2 w; w.x = pk2(y.x, y.y); w.y = pk2(y.z, y.w); ((u32x2*)ob)[lane + 64 * j] = w; } }
}
__global__ __launch_bounds__(512) void k_ln(const float* z, const float* g, const float* b, float* of, bf16_t* ob) {
    const int wave = threadIdx.x >> 6, lane = threadIdx.x & 63;
    for (int m = blockIdx.x * 8 + wave; m < MT; m += gridDim.x * 8) ln_row(z + (size_t)m * DM, g, b, of + (size_t)m * DM, ob ? ob + (size_t)m * DM : nullptr, lane);
}

enum { EPI_IN_E = 0, EPI_UQ, EPI_UKV, EPI_OUT, EPI_IN_O };
struct EpiArgs { Bufs B; const int* pos; const float* res; float* zout; };
template <int EPI> __device__ __forceinline__ void epi_dispatch(const EpiArgs& E, int row, int col0, float* v) {
    if (EPI == EPI_IN_E) epi_inproj_even(E.B, E.pos, row, col0, v);
    else if (EPI == EPI_UQ) epi_upq(E.B, E.pos, row, col0, v, rstd_from(E.B.SSQQ, row));
    else if (EPI == EPI_UKV) epi_upkv(E.B, row, col0, v, rstd_from(E.B.SSQKV, row));
    else if (EPI == EPI_IN_O) epi_inproj_odd(E.B, E.pos, row, col0, v);
    else { const float* r = E.res + (size_t)row * DM + col0; float* z = E.zout + (size_t)row * DM + col0;
#pragma unroll
        for (int j = 0; j < 8; ++j) z[j] = DN_ALPHA * r[j] + v[j]; }
}
template <int EPI> __global__ __launch_bounds__(256) void k_gemm_naive(const bf16_t* A, int lda, const bf16_t* A2, int lda2, int K1, const bf16_t* Bt, int K, EpiArgs E) {
    __shared__ float As[32][66]; __shared__ float Bs[32][66];
    const int tid = threadIdx.x, tm = blockIdx.y * 64, tn = blockIdx.x * 64;
    const int tr = tid >> 3, tc = tid & 7;
    float acc[2][8] = {};
    const int lr = tid >> 2, lk = (tid & 3) * 8;
    for (int k0 = 0; k0 < K; k0 += 32) {
        const bf16_t* ap = (k0 < K1) ? A + (size_t)(tm + lr) * lda + k0 + lk : A2 + (size_t)(tm + lr) * lda2 + (k0 - K1) + lk;
        const u32x4 av = *(const u32x4*)ap; const u32x4 bv = *(const u32x4*)(Bt + (size_t)(tn + lr) * K + k0 + lk);
        As[lk + 0][lr] = bflo(av.x); As[lk + 1][lr] = bfhi(av.x); As[lk + 2][lr] = bflo(av.y); As[lk + 3][lr] = bfhi(av.y); As[lk + 4][lr] = bflo(av.z); As[lk + 5][lr] = bfhi(av.z); As[lk + 6][lr] = bflo(av.w); As[lk + 7][lr] = bfhi(av.w);
        Bs[lk + 0][lr] = bflo(bv.x); Bs[lk + 1][lr] = bfhi(bv.x); Bs[lk + 2][lr] = bflo(bv.y); Bs[lk + 3][lr] = bfhi(bv.y); Bs[lk + 4][lr] = bflo(bv.z); Bs[lk + 5][lr] = bfhi(bv.z); Bs[lk + 6][lr] = bflo(bv.w); Bs[lk + 7][lr] = bfhi(bv.w);
        __syncthreads();
#pragma unroll 8
        for (int kk = 0; kk < 32; ++kk) { const float a0 = As[kk][2 * tr], a1 = As[kk][2 * tr + 1];
#pragma unroll
            for (int j = 0; j < 8; ++j) { const float bb = Bs[kk][tc * 8 + j]; acc[0][j] += a0 * bb; acc[1][j] += a1 * bb; } }
        __syncthreads();
    }
    epi_dispatch<EPI>(E, tm + 2 * tr, tn + tc * 8, acc[0]); epi_dispatch<EPI>(E, tm + 2 * tr + 1, tn + tc * 8, acc[1]);
}
__global__ __launch_bounds__(256) void k_ssq_naive(Bufs B) {
    const int wave = threadIdx.x >> 6, lane = threadIdx.x & 63; const int m = blockIdx.x * 4 + wave;
    for (int t = 0; t < 2; ++t) { const bf16_t* src = (t ? B.MKV : B.MQ) + (size_t)m * 256 + lane * 4; float s = 0.f;
        for (int j = 0; j < 4; ++j) { const float v = bf2f(src[j]); s += v * v; } s = wave_sum(s);
        if (lane == 0) { float* d = (t ? B.SSQKV : B.SSQQ) + (size_t)m * 4; d[0] = s; d[1] = 0.f; d[2] = 0.f; d[3] = 0.f; } }
}
__global__ __launch_bounds__(256) void k_kpart_naive(Bufs B) {
    const int pb = blockIdx.x;
    for (int c = threadIdx.x; c < 1024; c += 256) { float s = 0.f; for (int r = 0; r < 256; ++r) s += bf2f(B.KB[(size_t)(pb * 256 + r) * 1024 + c]); B.KPART[(size_t)pb * 2048 + c] = s; B.KPART[(size_t)pb * 2048 + 1024 + c] = 0.f; }
}

__global__ __launch_bounds__(256) void k_ret_naive(Bufs B) {
    const int wave = threadIdx.x >> 6, lane = threadIdx.x & 63; const int gwv = blockIdx.x * 4 + wave; const int row = gwv >> 2, h = gwv & 3;
    const int b0 = (row / SEQ) * SEQ, ni = (row - b0) >> 7;
    float q[4]; { const u32x2 w = *(const u32x2*)(B.QR + (size_t)row * 1024 + h * 256 + lane * 4); q[0] = bflo(w.x); q[1] = bfhi(w.x); q[2] = bflo(w.y); q[3] = bfhi(w.y); }
    float acc[8] = {}; const float gC = 128.0f * gamma_log2(h);
    for (int j = b0; j <= row; ++j) {
        const u32x2 kw = *(const u32x2*)(B.KR + (size_t)j * 1024 + h * 256 + lane * 4);
        float d = q[0] * bflo(kw.x) + q[1] * bfhi(kw.x) + q[2] * bflo(kw.y) + q[3] * bfhi(kw.y); d = wave_sum(d);
        const int nj = (j - b0) >> 7; const float w = d * exp2f(gC * (float)(ni - nj));
        const float pw = bf2f((bf16_t)f2bf(w));
        const u32x4 vv = *(const u32x4*)(B.VR + (size_t)j * 2048 + h * 512 + lane * 8);
        acc[0] += pw * bflo(vv.x); acc[1] += pw * bfhi(vv.x); acc[2] += pw * bflo(vv.y); acc[3] += pw * bfhi(vv.y); acc[4] += pw * bflo(vv.z); acc[5] += pw * bfhi(vv.z); acc[6] += pw * bflo(vv.w); acc[7] += pw * bfhi(vv.w);
    }
    float s = 0.f; for (int j = 0; j < 8; ++j) s += acc[j]; const float mean = wave_sum(s) * (1.f / 512.f);
    float s2 = 0.f; for (int j = 0; j < 8; ++j) { acc[j] -= mean; s2 += acc[j] * acc[j]; } const float rstd = 1.f / sqrtf(wave_sum(s2) * (1.f / 512.f) + LN_EPS);
    bf16_t* gp = B.GR + (size_t)row * 2048 + h * 512 + lane * 8; const u32x4 gw = *(const u32x4*)gp;
    float o[8]; o[0] = acc[0] * rstd * bflo(gw.x); o[1] = acc[1] * rstd * bfhi(gw.x); o[2] = acc[2] * rstd * bflo(gw.y); o[3] = acc[3] * rstd * bfhi(gw.y);
    o[4] = acc[4] * rstd * bflo(gw.z); o[5] = acc[5] * rstd * bfhi(gw.z); o[6] = acc[6] * rstd * bflo(gw.w); o[7] = acc[7] * rstd * bfhi(gw.w);
    store8bf(gp, o);
}
__global__ __launch_bounds__(256) void k_mla_naive(Bufs B) {
    const int wave = threadIdx.x >> 6, lane = threadIdx.x & 63; const int gwv = blockIdx.x * 4 + wave; const int row = gwv >> 3, hd = gwv & 7;
    const int b0 = (row / SEQ) * SEQ;
    const bf16_t* qp = B.QM + (size_t)row * 1536 + hd * 192; const float q0 = bf2f(qp[lane]), q1 = bf2f(qp[64 + lane]), q2 = bf2f(qp[128 + lane]);
    float m = -1e30f, l = 0.f, a0 = 0.f, a1 = 0.f;
    for (int j = b0; j <= row; ++j) {
        const bf16_t* kn = B.KN + (size_t)j * 1024 + hd * 128; float d = q0 * bf2f(kn[lane]) + q1 * bf2f(kn[64 + lane]) + q2 * bf2f(B.KPE[(size_t)j * 64 + lane]); d = wave_sum(d);
        const float mn = fmaxf(m, d), al = exp2f(m - mn), pe = exp2f(d - mn); m = mn;
        const unsigned vw = *(const unsigned*)(B.VM + (size_t)j * 1024 + hd * 128 + lane * 2); const float pb = bf2f((bf16_t)f2bf(pe));
        l = l * al + pe; a0 = a0 * al + pb * bflo(vw); a1 = a1 * al + pb * bfhi(vw);
    }
    bf16_t* gp = B.GM + (size_t)row * 1024 + hd * 128 + lane * 2; const unsigned gw = *(const unsigned*)gp;
    *(unsigned*)gp = pk2(a0 / l * bflo(gw), a1 / l * bfhi(gw));
}
__device__ __forceinline__ unsigned moba_select(const float (&gate)[8], int qb) {
    unsigned mask = 0;
#pragma unroll
    for (int n = 0; n < 8; ++n) { int cnt = 0;
#pragma unroll
        for (int mm = 0; mm < 8; ++mm) cnt += (mm != n) && (mm < qb) && (gate[mm] > gate[n] || (gate[mm] == gate[n] && mm < n));
        if (n < qb && cnt < 3) mask |= 1u << n; }
    return mask;
}
__global__ __launch_bounds__(256) void k_moba_naive(Bufs B) {
    const int wave = threadIdx.x >> 6, lane = threadIdx.x & 63; const int gwv = blockIdx.x * 4 + wave; const int row = gwv >> 4, h = gwv & 15;
    const int b = row / SEQ, b0 = b * SEQ, s = row - b0, qb = s >> 8;
    const float q = bf2f(B.QB[(size_t)row * 1024 + h * 64 + lane]);
    float gate[8];
#pragma unroll
    for (int n = 0; n < 8; ++n) { float g = 0.f; if (n < qb) { const float* kp = B.KPART + (size_t)(b * 8 + n) * 2048 + h * 64 + lane; g = wave_sum(q * (kp[0] + kp[1024]) * (1.f / 256.f)); } gate[n] = g; }
    const unsigned mask = moba_select(gate, qb) | (1u << qb);
    float m = -1e30f, l = 0.f, a = 0.f;
    for (int n = 0; n <= qb; ++n) { if (!((mask >> n) & 1)) continue;
        const int j1 = (n == qb) ? row : b0 + n * 256 + 255;
        for (int j = b0 + n * 256; j <= j1; ++j) {
            float d = wave_sum(q * bf2f(B.KB[(size_t)j * 1024 + h * 64 + lane]));
            const float mn = fmaxf(m, d), al = exp2f(m - mn), pe = exp2f(d - mn); m = mn; const float pb = bf2f((bf16_t)f2bf(pe));
            l = l * al + pe; a = a * al + pb * bf2f(B.VB[(size_t)j * 1024 + h * 64 + lane]);
        } }
    bf16_t* gp = B.GB + (size_t)row * 1024 + h * 64 + lane; *gp = (bf16_t)f2bf(a / l * bf2f(*gp));
}

extern "C" void kernel_launch(void* const* d_in, const int* in_sizes, int n_in, void* d_out, int out_size, void* d_ws, size_t ws_size, hipStream_t stream) {
    if (n_in != 12 || out_size != MT * DM || ws_size < WS_END) { fprintf(stderr, "kernel_launch: unexpected shapes (n_in %d out %d ws %zu)\n", n_in, out_size, ws_size); return; }
    Params p{};
    p.x = (const float*)d_in[0]; p.pos = (const int*)d_in[1]; p.w_in_e = (const float*)d_in[2]; p.qn_g = (const float*)d_in[3]; p.w_uq = (const float*)d_in[4]; p.kvn_g = (const float*)d_in[5];
    p.w_ukv = (const float*)d_in[6]; p.w_out_e = (const float*)d_in[7]; p.w_in_o = (const float*)d_in[8]; p.w_out_o = (const float*)d_in[9]; p.ln_g = (const float*)d_in[10]; p.ln_b = (const float*)d_in[11];
    p.out = (float*)d_out; p.ws = (unsigned char*)d_ws;
    const Bufs B = make_bufs(p);
    static bool attr = false;
    if (!attr) { attr = true; (void)hipFuncSetAttribute((const void*)k_prologue, hipFuncAttributeMaxDynamicSharedMemorySize, 8 * 64 * 33 * 4); }
    k_prologue<<<1024, 512, 8 * 64 * 33 * 4, stream>>>(p);
    EpiArgs E{}; E.B = B; E.pos = p.pos;
    k_gemm_naive<EPI_IN_E><<<dim3(N1 / 64, MT / 64), 256, 0, stream>>>(B.XB, 1024, B.XB, 1024, 1 << 30, B.W1t, 1024, E);
    k_ssq_naive<<<MT / 4, 256, 0, stream>>>(B);
    k_ret_naive<<<MT * 4 / 4, 256, 0, stream>>>(B);
    k_gemm_naive<EPI_UQ><<<dim3(1536 / 64, MT / 64), 256, 0, stream>>>(B.MQ, 256, B.MQ, 256, 1 << 30, B.Wuqt, 256, E);
    k_gemm_naive<EPI_UKV><<<dim3(2048 / 64, MT / 64), 256, 0, stream>>>(B.MKV, 256, B.MKV, 256, 1 << 30, B.Wukvt, 256, E);
    k_mla_naive<<<MT * 8 / 4, 256, 0, stream>>>(B);
    E.res = p.x; E.zout = B.Z;
    k_gemm_naive<EPI_OUT><<<dim3(1024 / 64, MT / 64), 256, 0, stream>>>(B.GR, 2048, B.GM, 1024, 2048, B.Wo0t, 3072, E);
    k_ln<<<1024, 512, 0, stream>>>(B.Z, p.ln_g, p.ln_b, B.X1, B.X1B);
    k_gemm_naive<EPI_IN_O><<<dim3(4096 / 64, MT / 64), 256, 0, stream>>>(B.X1B, 1024, B.X1B, 1024, 1 << 30, B.W3t, 1024, E);
    k_kpart_naive<<<64, 256, 0, stream>>>(B);
    k_moba_naive<<<MT * 16 / 4, 256, 0, stream>>>(B);
    E.res = B.X1; E.zout = B.Z1;
    k_gemm_naive<EPI_OUT><<<dim3(1024 / 64, MT / 64), 256, 0, stream>>>(B.GB, 1024, B.GB, 1024, 1 << 30, B.Wo1t, 1024, E);
    k_ln<<<1024, 512, 0, stream>>>(B.Z1, p.ln_g + DM, p.ln_b + DM, p.out, nullptr);
}
```

```cpp
#include <hip/hip_runtime.h>
#include <cstdio>
#include <cstdint>
#ifndef FAST_GEMM
#define FAST_GEMM 1
#endif
#ifndef DIAG
#define DIAG 0
#endif
#ifndef FAST_RET
#define FAST_RET 1
#endif
#ifndef FAST_ATTN
#define FAST_ATTN 1
#endif

constexpr int NB = 8, SEQ = 2048, DM = 1024, MT = NB * SEQ;
constexpr int N1 = 7936;
constexpr int C_RQ = 0, C_RK = 1024, C_RV = 2048, C_RG = 4096, C_MQ = 6144, C_MKV = 6400, C_MG = 6656, C_MKR = 7680, C_PAD = 7744;
constexpr float LN_EPS = 1e-5f, RMS_EPS = 1e-6f;
constexpr float DN_ALPHA = 1.4142135623730951f;
constexpr float LOG2_THETA = 13.287712379549449f;
constexpr float QS_MLA = 0.10411754627697264f;
constexpr float QS_MOBA = 0.18033688011112042f;

typedef unsigned short bf16_t;
typedef float f32x4 __attribute__((ext_vector_type(4)));
typedef unsigned u32x4 __attribute__((ext_vector_type(4)));
typedef unsigned u32x2 __attribute__((ext_vector_type(2)));

constexpr size_t MiB = 1u << 20;
constexpr size_t WS_CTL = 0;
constexpr size_t WS_W1T = 1 * MiB;
constexpr size_t WS_WUQT = WS_W1T + (size_t)N1 * 1024 * 2;
constexpr size_t WS_WUKVT = WS_WUQT + (size_t)1536 * 256 * 2;
constexpr size_t WS_WO0T = WS_WUKVT + (size_t)2048 * 256 * 2;
constexpr size_t WS_W3T = WS_WO0T + (size_t)1024 * 3072 * 2;
constexpr size_t WS_WO1T = WS_W3T + (size_t)4096 * 1024 * 2;
constexpr size_t WS_WEND = WS_WO1T + (size_t)1024 * 1024 * 2;
static_assert(WS_WEND <= 35 * MiB, "weights");
constexpr size_t WS_SSQQ = 35 * MiB;
constexpr size_t WS_SSQKV = WS_SSQQ + (size_t)MT * 16;
constexpr size_t WS_KPART = WS_SSQKV + (size_t)MT * 16;
constexpr size_t WS_KPE = 36 * MiB;
constexpr size_t WS_R39 = 39 * MiB;
constexpr size_t WS_R71 = 71 * MiB;
constexpr size_t WS_R135 = 135 * MiB;
constexpr size_t WS_R199 = 199 * MiB;
constexpr size_t WS_R231 = 231 * MiB;
constexpr size_t WS_END = 256 * MiB;

struct Params {
    const float* x; const int* pos;
    const float *w_in_e, *qn_g, *w_uq, *kvn_g, *w_ukv, *w_out_e, *w_in_o, *w_out_o, *ln_g, *ln_b;
    float* out; unsigned char* ws;
};
struct Bufs {
    bf16_t *W1t, *Wuqt, *Wukvt, *Wo0t, *W3t, *Wo1t;
    float *SSQQ, *SSQKV, *KPART; bf16_t* KPE;
    bf16_t *XB, *VM, *X1B;
    bf16_t *GR, *QB, *KB; float* Z1;
    bf16_t *VR, *QM, *VB, *GB; float* Z;
    bf16_t *QR, *KN; bf16_t *MQ, *MKV;
    bf16_t *KR, *GM; float* X1;
};
__host__ __device__ inline Bufs make_bufs(const Params& p) {
    Bufs b; unsigned char* w = p.ws;
    b.W1t = (bf16_t*)(w + WS_W1T); b.Wuqt = (bf16_t*)(w + WS_WUQT); b.Wukvt = (bf16_t*)(w + WS_WUKVT); b.Wo0t = (bf16_t*)(w + WS_WO0T); b.W3t = (bf16_t*)(w + WS_W3T); b.Wo1t = (bf16_t*)(w + WS_WO1T);
    b.SSQQ = (float*)(w + WS_SSQQ); b.SSQKV = (float*)(w + WS_SSQKV); b.KPART = (float*)(w + WS_KPART); b.KPE = (bf16_t*)(w + WS_KPE);
    b.XB = (bf16_t*)(w + WS_R39); b.VM = b.XB; b.X1B = b.XB;
    b.GR = (bf16_t*)(w + WS_R71); b.QB = b.GR; b.KB = b.GR + (size_t)MT * 1024; b.Z1 = (float*)(w + WS_R71);
    b.VR = (bf16_t*)(w + WS_R135); b.QM = b.VR; b.Z = (float*)(w + WS_R135); b.VB = b.VR; b.GB = b.VR + (size_t)MT * 1024;
    b.QR = (bf16_t*)(w + WS_R199); b.KN = b.QR;
    b.MQ = (bf16_t*)(w + WS_R231); b.MKV = b.MQ + (size_t)MT * 256;
    b.KR = (bf16_t*)p.out; b.X1 = p.out; b.GM = (bf16_t*)((unsigned char*)p.out + 32 * MiB);
    return b;
}

__device__ __forceinline__ unsigned f2bf(float f) { unsigned u = __builtin_bit_cast(unsigned, f); return (u + 0x7fffu + ((u >> 16) & 1u)) >> 16; }
__device__ __forceinline__ unsigned pk2(float lo, float hi) { return f2bf(lo) | (f2bf(hi) << 16); }
__device__ __forceinline__ float bf2f(bf16_t v) { return __builtin_bit_cast(float, (unsigned)v << 16); }
__device__ __forceinline__ float bflo(unsigned w) { return __builtin_bit_cast(float, w << 16); }
__device__ __forceinline__ float bfhi(unsigned w) { return __builtin_bit_cast(float, w & 0xffff0000u); }
__device__ __forceinline__ float wave_sum(float v) {
#pragma unroll
    for (int o = 1; o < 64; o <<= 1) v += __shfl_xor(v, o);
    return v;
}
__device__ __forceinline__ float silu_f(float x) { return x / (1.0f + __expf(-x)); }
__device__ __forceinline__ void sincos_rev(float ang, float& s, float& c) {
    float r = ang * 0.15915494309189535f; r = r - floorf(r);
    s = __builtin_amdgcn_sinf(r); c = __builtin_amdgcn_cosf(r);
}
__device__ __forceinline__ float gamma_log2(int h) { return h == 0 ? -0.04580368961312479f : h == 1 ? -0.02272007650008353f : h == 2 ? -0.011315313227834146f : -0.005646563141142063f; }
__device__ __forceinline__ void store8bf(bf16_t* p, const float* v) {
    u32x4 w; w.x = pk2(v[0], v[1]); w.y = pk2(v[2], v[3]); w.z = pk2(v[4], v[5]); w.w = pk2(v[6], v[7]); *(u32x4*)p = w;
}
template <bool RETNET> __device__ __forceinline__ void rot4(float* v, float posf, int i0) {
#pragma unroll
    for (int p = 0; p < 4; ++p) {
        const float inv = RETNET ? exp2f(-(LOG2_THETA / 127.0f) * (float)(i0 + p)) : exp2f(-(LOG2_THETA / 32.0f) * (float)(i0 + p));
        float s, c; sincos_rev(posf * inv, s, c);
        const float a = v[2 * p], b = v[2 * p + 1];
        v[2 * p] = a * c - b * s; v[2 * p + 1] = b * c + a * s;
    }
}

__device__ __forceinline__ void epi_inproj_even(const Bufs& B, const int* pos, int row, int col0, float* v) {
    if (col0 < C_RV) {
        const bool isk = col0 >= C_RK; const int c = col0 - (isk ? C_RK : 0), h = c >> 8, i0 = (c & 255) >> 1, ic = row & 127;
        rot4<true>(v, (float)pos[row], i0);
        const float e = (float)(ic + 1) * gamma_log2(h);
        const float sc = isk ? exp2f(-e) * 0.0625f : exp2f(e);
#pragma unroll
        for (int j = 0; j < 8; ++j) v[j] *= sc;
        store8bf((isk ? B.KR : B.QR) + (size_t)row * 1024 + c, v);
    } else if (col0 < C_RG) { store8bf(B.VR + (size_t)row * 2048 + (col0 - C_RV), v);
    } else if (col0 < C_MQ) {
#pragma unroll
        for (int j = 0; j < 8; ++j) v[j] = silu_f(v[j]);
        store8bf(B.GR + (size_t)row * 2048 + (col0 - C_RG), v);
    } else if (col0 < C_MKV) { store8bf(B.MQ + (size_t)row * 256 + (col0 - C_MQ), v);
    } else if (col0 < C_MG) { store8bf(B.MKV + (size_t)row * 256 + (col0 - C_MKV), v);
    } else if (col0 < C_MKR) {
#pragma unroll
        for (int j = 0; j < 8; ++j) v[j] = silu_f(v[j]);
        store8bf(B.GM + (size_t)row * 1024 + (col0 - C_MG), v);
    } else if (col0 < C_PAD) {
        rot4<false>(v, (float)pos[row], (col0 - C_MKR) >> 1);
        store8bf(B.KPE + (size_t)row * 64 + (col0 - C_MKR), v);
    }
}
__device__ __forceinline__ float rstd_from(const float* ssq, int row) {
    const f32x4 s = *(const f32x4*)(ssq + (size_t)row * 4);
    return 1.0f / sqrtf(((s.x + s.y) + (s.z + s.w)) * (1.0f / 256.0f) + RMS_EPS);
}
__device__ __forceinline__ void epi_upq(const Bufs& B, const int* pos, int row, int col0, float* v, float rstd) {
    const int l = col0 % 192;
#pragma unroll
    for (int j = 0; j < 8; ++j) v[j] *= rstd;
    if (l >= 128) rot4<false>(v, (float)pos[row], (l - 128) >> 1);
#pragma unroll
    for (int j = 0; j < 8; ++j) v[j] *= QS_MLA;
    store8bf(B.QM + (size_t)row * 1536 + col0, v);
}
__device__ __forceinline__ void epi_upkv(const Bufs& B, int row, int col0, float* v, float rstd) {
    const int hd = col0 >> 8, l = col0 & 255;
#pragma unroll
    for (int j = 0; j < 8; ++j) v[j] *= rstd;
    if (l < 128) store8bf(B.KN + (size_t)row * 1024 + hd * 128 + l, v);
    else store8bf(B.VM + (size_t)row * 1024 + hd * 128 + (l - 128), v);
}
__device__ __forceinline__ void epi_inproj_odd(const Bufs& B, const int* pos, int row, int col0, float* v) {
    if (col0 < 2048) {
        const bool isk = col0 >= 1024; const int c = col0 & 1023;
        rot4<false>(v, (float)pos[row], (c & 63) >> 1);
        if (!isk) {
#pragma unroll
            for (int j = 0; j < 8; ++j) v[j] *= QS_MOBA;
        }
        store8bf((isk ? B.KB : B.QB) + (size_t)row * 1024 + c, v);
    } else if (col0 < 3072) { store8bf(B.VB + (size_t)row * 1024 + (col0 - 2048), v);
    } else {
#pragma unroll
        for (int j = 0; j < 8; ++j) v[j] = silu_f(v[j]);
        store8bf(B.GB + (size_t)row * 1024 + (col0 - 3072), v);
    }
}

enum { WK_IN_E = 0, WK_UQ, WK_UKV, WK_OUT_E, WK_IN_O, WK_OUT_O };
__device__ __forceinline__ int srccol(int kind, int rho) {
    switch (kind) {
    case WK_IN_E:
        if (rho < C_MG) return rho;
        if (rho < C_MKR) return 6720 + (rho - C_MG);
        if (rho < C_PAD) { const int l = rho - C_MKR; return 6656 + 32 * (l & 1) + (l >> 1); }
        return -1;
    case WK_UQ: { const int hd = rho / 192, l = rho % 192; if (l < 128) return rho; const int lp = l - 128; return hd * 192 + 128 + 32 * (lp & 1) + (lp >> 1); }
    case WK_IN_O: { if (rho >= 2048) return rho; const int l = rho & 63; return (rho & ~63) + 32 * (l & 1) + (l >> 1); }
    default: return rho;
    }
}
__device__ __forceinline__ void transpose_item(const float* W, const float* gain, int kind, int K, int N, bf16_t* WT, float* scr  , int item, int lane) {
    const int nblk_k = K / 64; const int rb = item / nblk_k, kb = item % nblk_k; const int k0 = kb * 64, r0 = rb * 32;
    const int sc = srccol(kind, r0 + (lane & 31));
#pragma unroll 8
    for (int i = 0; i < 32; ++i) { const int kk = 2 * i + (lane >> 5); float val = 0.f; if (sc >= 0) { val = W[(size_t)(k0 + kk) * N + sc]; if (gain) val *= gain[k0 + kk]; } scr[kk * 33 + (lane & 31)] = val; }
    __builtin_amdgcn_s_waitcnt(0xc07f); __builtin_amdgcn_wave_barrier();
    const int c = lane & 7;
#pragma unroll
    for (int j = 0; j < 4; ++j) { const int n = (lane >> 3) + 8 * j; const float* s = scr + (8 * c) * 33 + n;
        u32x4 o; o.x = pk2(s[0 * 33], s[1 * 33]); o.y = pk2(s[2 * 33], s[3 * 33]); o.z = pk2(s[4 * 33], s[5 * 33]); o.w = pk2(s[6 * 33], s[7 * 33]);
        *(u32x4*)(WT + (size_t)(r0 + n) * K + k0 + 8 * c) = o; }
    __builtin_amdgcn_s_waitcnt(0xc07f); __builtin_amdgcn_wave_barrier();
}
constexpr int IT_W1 = (1024 / 64) * (N1 / 32), IT_UQ = (256 / 64) * (1536 / 32), IT_UKV = (256 / 64) * (2048 / 32), IT_O0 = (3072 / 64) * (1024 / 32), IT_W3 = (1024 / 64) * (4096 / 32), IT_O1 = (1024 / 64) * (1024 / 32);
constexpr int IT_ALL = IT_W1 + IT_UQ + IT_UKV + IT_O0 + IT_W3 + IT_O1;
__device__ __forceinline__ void phase_prologue(const Params& p, const Bufs& B, float* lds_f, int gw, int ngw, int wave, int lane) {
    float* scr = lds_f + wave * (64 * 33);
    for (int it = gw; it < IT_ALL; it += ngw) {
        int r = it;
        if (r < IT_W1) { transpose_item(p.w_in_e, nullptr, WK_IN_E, 1024, 7744, B.W1t, scr, r, lane); continue; } r -= IT_W1;
        if (r < IT_UQ) { transpose_item(p.w_uq, p.qn_g, WK_UQ, 256, 1536, B.Wuqt, scr, r, lane); continue; } r -= IT_UQ;
        if (r < IT_UKV) { transpose_item(p.w_ukv, p.kvn_g, WK_UKV, 256, 2048, B.Wukvt, scr, r, lane); continue; } r -= IT_UKV;
        if (r < IT_O0) { transpose_item(p.w_out_e, nullptr, WK_OUT_E, 3072, 1024, B.Wo0t, scr, r, lane); continue; } r -= IT_O0;
        if (r < IT_W3) { transpose_item(p.w_in_o, nullptr, WK_IN_O, 1024, 4096, B.W3t, scr, r, lane); continue; } r -= IT_W3;
        transpose_item(p.w_out_o, nullptr, WK_OUT_O, 1024, 1024, B.Wo1t, scr, r, lane);
    }
    for (int m = gw; m < MT; m += ngw) {
        const f32x4* xr = (const f32x4*)(p.x + (size_t)m * DM) + lane; u32x2* o = (u32x2*)(B.XB + (size_t)m * DM) + lane;
#pragma unroll
        for (int j = 0; j < 4; ++j) { const f32x4 v = xr[64 * j]; u32x2 w; w.x = pk2(v.x, v.y); w.y = pk2(v.z, v.w); o[64 * j] = w; }
    }
}
__global__ __launch_bounds__(512) void k_prologue(Params p) {
    extern __shared__ __attribute__((aligned(16))) unsigned char lds[];
    const Bufs B = make_bufs(p);
    const int wave = threadIdx.x >> 6, lane = threadIdx.x & 63;
    phase_prologue(p, B, (float*)lds, blockIdx.x * 8 + wave, gridDim.x * 8, wave, lane);
}

__device__ __forceinline__ void ln_row(const float* z, const float* g, const float* b, float* of, bf16_t* ob, int lane) {
    const f32x4* zr = (const f32x4*)z + lane; f32x4 v[4]; float s = 0.f;
#pragma unroll
    for (int j = 0; j < 4; ++j) { v[j] = zr[64 * j]; s += (v[j].x + v[j].y) + (v[j].z + v[j].w); }
    const float mean = wave_sum(s) * (1.f / DM); float s2 = 0.f;
#pragma unroll
    for (int j = 0; j < 4; ++j) { v[j] = v[j] - mean; s2 += (v[j].x * v[j].x + v[j].y * v[j].y) + (v[j].z * v[j].z + v[j].w * v[j].w); }
    const float rstd = 1.f / sqrtf(wave_sum(s2) * (1.f / DM) + LN_EPS);
#pragma unroll
    for (int j = 0; j < 4; ++j) { const f32x4 gg = ((const f32x4*)g)[lane + 64 * j], bb = ((const f32x4*)b)[lane + 64 * j]; const f32x4 y = v[j] * rstd * gg + bb;
        ((f32x4*)of)[lane + 64 * j] = y; if (ob) { u32x2 w; w.x = pk2(y.x, y.y); w.y = pk2(y.z, y.w); ((u32x2*)ob)[lane + 64 * j] = w; } }
}
__global__ __launch_bounds__(512) void k_ln(const float* z, const float* g, const float* b, float* of, bf16_t* ob) {
    const int wave = threadIdx.x >> 6, lane = threadIdx.x & 63;
    for (int m = blockIdx.x * 8 + wave; m < MT; m += gridDim.x * 8) ln_row(z + (size_t)m * DM, g, b, of + (size_t)m * DM, ob ? ob + (size_t)m * DM : nullptr, lane);
}

namespace pg8 {
#define PG8_LAS __attribute__((address_space(3)))
typedef short bf16x8 __attribute__((ext_vector_type(8)));
constexpr int BM = 256, BK = 64, HALF = 128, HTB = HALF * BK * 2, STAGE_BYTES = 8 * HTB, NXCD = 8, WGM = 8;
__host__ __device__ __forceinline__ int lds_byte(int r, int c) { const int st = (r >> 4) * 2 + (c >> 5), rr = r & 15, cc = c & 31, ob = rr * 64 + cc * 2; return st * 1024 + (ob ^ (((ob >> 9) & 1) << 5)); }
__host__ __device__ __forceinline__ void stage_rc(int b, int& R, int& C) { const int st = b / 1024, sb = b % 1024, swz = sb ^ (((sb >> 9) & 1) << 5); R = (st >> 1) * 16 + swz / 64; C = (st & 1) * 32 + (swz % 64) / 2; }
__host__ __device__ __forceinline__ int perm32(int rho) { const int n = rho >> 4, i = rho & 15; return 8 * (i >> 2) + 4 * n + (i & 3); }
struct Unit { int pm, pn; };
struct Gemm { const bf16_t* A1; int lda1; const bf16_t* A2; int lda2; int nt1; const bf16_t* Bt; int M, N, K; };
struct StaticOrder {
    int nM, nN, nwg, G, c;
    __host__ __device__ void init(int M, int N, int G_, int c_) { nM = M / BM; nN = N / BM; nwg = nM * nN; G = G_; c = c_; }
    __host__ __device__ bool next(int i, Unit& u) const {
        const long L = (long)i * G + c; if (L >= nwg) return false;
        int wgid = (int)L; { const int q = nwg / NXCD, r = nwg % NXCD, xcd = wgid % NXCD, off = wgid / NXCD; wgid = (xcd < r ? xcd * (q + 1) : r * (q + 1) + (xcd - r) * q) + off; }
        const int nig = WGM * nN, gid = wgid / nig, fm = gid * WGM, gsz = (nM - fm) < WGM ? (nM - fm) : WGM;
        u.pm = fm + ((wgid % nig) % gsz); u.pn = (wgid % nig) / gsz; return true;
    }
};
template <class Epi, bool TWOSEG>
__device__ __forceinline__ void gemm_phase(PG8_LAS unsigned char* lds, const Gemm g, const StaticOrder& S, const Epi& E) {
    const int tid = threadIdx.x, wid = __builtin_amdgcn_readfirstlane(tid >> 6), lane = tid & 63, wr = wid >> 2, wc = wid & 3, fr = lane & 15, fq = lane >> 4;
    const int K = g.K, nt = K / BK, nt1 = TWOSEG ? g.nt1 : nt;
    unsigned voffA[2], voffA2[2], voffB[2];
#pragma unroll
    for (int i = 0; i < 2; ++i) { int R, C; stage_rc(tid * 16 + i * 8192, R, C); const int Rb = (R & ~31) + perm32(R & 31);
        voffA[i] = (unsigned)(R * g.lda1 + C) * 2u; voffA2[i] = TWOSEG ? (unsigned)(R * g.lda2 + C) * 2u : 0u; voffB[i] = (unsigned)(Rb * K + C) * 2u; }
    const size_t kstep = (size_t)(BK * 2);
    const size_t hstepB = (size_t)HALF * K * 2, tstepB = 2 * hstepB;
    const size_t hsA1 = (size_t)HALF * g.lda1 * 2, hsA2 = TWOSEG ? (size_t)HALF * g.lda2 * 2 : 0;
    const unsigned ldsw = (unsigned)wid * 1024u;
    const int aoff = lds_byte(wr * 64 + fr, fq * 8), boff = lds_byte(wc * 32 + fr, fq * 8);
#define PG8_SA(b, h) (((b) * 2 + (h)) * HTB)
#define PG8_SB(b, h) ((4 + (b) * 2 + (h)) * HTB)
#define PG8_GLDS(bufoff, gp, v0, v1) do { \
        __builtin_amdgcn_global_load_lds((const unsigned*)((gp) + (v0)), (PG8_LAS unsigned*)(lds + (bufoff) + ldsw), 16, 0, 0); \
        __builtin_amdgcn_global_load_lds((const unsigned*)((gp) + (v1)), (PG8_LAS unsigned*)(lds + (bufoff) + ldsw + 8192), 16, 0, 0); } while (0)
#define PG8_STAGEB(bufoff, gbase) PG8_GLDS(bufoff, (const char*)(gbase), voffB[0], voffB[1])
#define PG8_ATILE(pm_, tau_, P_, HS_, V0_, V1_) do { const int tau__ = (tau_); \
        if (!TWOSEG || tau__ < nt1) { P_ = (const char*)g.A1 + (size_t)(pm_) * 2 * hsA1 + (size_t)tau__ * kstep; HS_ = hsA1; V0_ = voffA[0]; V1_ = voffA[1]; } \
        else { P_ = (const char*)g.A2 + (size_t)(pm_) * 2 * hsA2 + (size_t)(tau__ - nt1) * kstep; HS_ = hsA2; V0_ = voffA2[0]; V1_ = voffA2[1]; } } while (0)
#define PG8_LDA(dst, b, h) do { _Pragma("unroll") for (int m = 0; m < 4; ++m) _Pragma("unroll") for (int k = 0; k < 2; ++k) dst[m][k] = *(const PG8_LAS bf16x8*)(lds + PG8_SA(b, h) + aoff + m * 2048 + k * 1024); } while (0)
#define PG8_LDB(dst, b, h) do { _Pragma("unroll") for (int n = 0; n < 2; ++n) _Pragma("unroll") for (int k = 0; k < 2; ++k) dst[n][k] = *(const PG8_LAS bf16x8*)(lds + PG8_SB(b, h) + boff + n * 2048 + k * 1024); } while (0)
#define PG8_MMA(ai, bj, At, Bt) do { __builtin_amdgcn_s_setprio(1); _Pragma("unroll") for (int m = 0; m < 4; ++m) _Pragma("unroll") for (int n = 0; n < 2; ++n) _Pragma("unroll") for (int k = 0; k < 2; ++k) \
        acc[ai][bj][m][n] = __builtin_amdgcn_mfma_f32_16x16x32_bf16(Bt[n][k], At[m][k], acc[ai][bj][m][n], 0, 0, 0); __builtin_amdgcn_s_setprio(0); } while (0)
#define PG8_WAIT_V(n) asm volatile("s_waitcnt vmcnt(" #n ")" ::: "memory")
#define PG8_WAIT_L(n) asm volatile("s_waitcnt lgkmcnt(" #n ")" ::: "memory")
#define PG8_BAR __builtin_amdgcn_s_barrier()
#define PG8_SCHED __builtin_amdgcn_sched_barrier(0)
    Unit cur, nxt; int ui = 0;
    if (!S.next(0, cur)) return;
    f32x4 acc[2][2][4][2];
#pragma unroll
    for (int a = 0; a < 2; ++a)
#pragma unroll
        for (int b = 0; b < 2; ++b)
#pragma unroll
            for (int m = 0; m < 4; ++m)
#pragma unroll
                for (int n = 0; n < 2; ++n) acc[a][b][m][n] = (f32x4){0.f, 0.f, 0.f, 0.f};
    bf16x8 At[4][2], B0[2][2], B1[2][2];
    const char* cB = (const char*)g.Bt + (size_t)cur.pn * tstepB;
    { const char *p0, *p1; size_t h0, h1; unsigned a0, a1, b0, b1;
      PG8_ATILE(cur.pm, 0, p0, h0, a0, a1); PG8_ATILE(cur.pm, 1, p1, h1, b0, b1);
      PG8_STAGEB(PG8_SB(0, 0), cB); PG8_STAGEB(PG8_SB(0, 1), cB + hstepB); PG8_GLDS(PG8_SA(0, 0), p0, a0, a1); PG8_GLDS(PG8_SA(0, 1), p0 + h0, a0, a1);
      if (wr == 1) PG8_BAR;
      PG8_WAIT_V(2); PG8_BAR;
      PG8_STAGEB(PG8_SB(1, 0), cB + kstep); PG8_GLDS(PG8_SA(1, 0), p1, b0, b1); PG8_STAGEB(PG8_SB(1, 1), cB + hstepB + kstep);
      PG8_WAIT_V(6); PG8_BAR; }
    for (;;) {
        const bool has_next = S.next(ui + 1, nxt);
        const int npm = has_next ? nxt.pm : cur.pm;
        const char* nB = has_next ? (const char*)g.Bt + (size_t)nxt.pn * tstepB : cB;
        for (int t = 0; t < nt; t += 2) {
            const bool last = (t == nt - 2);
            const char *pa1, *pa2, *pa3; size_t h1, h2, h3; unsigned v10, v11, v20, v21, v30, v31;
            PG8_ATILE(cur.pm, t + 1, pa1, h1, v10, v11);
            if (last) { PG8_ATILE(npm, 0, pa2, h2, v20, v21); PG8_ATILE(npm, 1, pa3, h3, v30, v31); }
            else { PG8_ATILE(cur.pm, t + 2, pa2, h2, v20, v21); PG8_ATILE(cur.pm, t + 3, pa3, h3, v30, v31); }
            const char* b2 = last ? nB : cB + (size_t)(t + 2) * kstep; const char* b3 = b2 + kstep;
            PG8_LDB(B0, 0, 0); PG8_LDB(B1, 0, 1); PG8_SCHED; PG8_LDA(At, 0, 0); PG8_GLDS(PG8_SA(1, 1), pa1 + h1, v10, v11);
            PG8_WAIT_V(8); PG8_WAIT_L(0); PG8_BAR; PG8_MMA(0, 0, At, B0); PG8_MMA(0, 1, At, B1); PG8_BAR; PG8_SCHED;
            PG8_LDA(At, 0, 1); PG8_STAGEB(PG8_SB(0, 0), b2); PG8_STAGEB(PG8_SB(0, 1), b2 + hstepB); PG8_GLDS(PG8_SA(0, 0), pa2, v20, v21);
            PG8_WAIT_V(8); PG8_WAIT_L(0); PG8_BAR; PG8_MMA(1, 0, At, B0); PG8_MMA(1, 1, At, B1); PG8_BAR; PG8_SCHED;
            PG8_LDB(B0, 1, 0); PG8_LDB(B1, 1, 1); PG8_SCHED; PG8_LDA(At, 1, 0); PG8_GLDS(PG8_SA(0, 1), pa2 + h2, v20, v21);
            PG8_WAIT_V(8); PG8_WAIT_L(0); PG8_BAR; PG8_MMA(0, 0, At, B0); PG8_MMA(0, 1, At, B1); PG8_BAR; PG8_SCHED;
            PG8_LDA(At, 1, 1); PG8_STAGEB(PG8_SB(1, 0), b3); PG8_STAGEB(PG8_SB(1, 1), b3 + hstepB); PG8_GLDS(PG8_SA(1, 0), pa3, v30, v31);
            PG8_WAIT_V(8); PG8_WAIT_L(0); PG8_BAR; PG8_MMA(1, 0, At, B0); PG8_MMA(1, 1, At, B1); PG8_BAR; PG8_SCHED;
        }
        if (wr == 0) PG8_BAR;
        E(acc, cur, wr, wc, fr, fq);
        if (!has_next) break;
#pragma unroll
        for (int a = 0; a < 2; ++a)
#pragma unroll
            for (int b = 0; b < 2; ++b)
#pragma unroll
                for (int m = 0; m < 4; ++m)
#pragma unroll
                    for (int n = 0; n < 2; ++n) acc[a][b][m][n] = (f32x4){0.f, 0.f, 0.f, 0.f};
        cur = nxt; cB = nB; ++ui;
        if (wr == 1) PG8_BAR;
    }
    PG8_WAIT_V(0);
    PG8_BAR;
#undef PG8_SA
#undef PG8_SB
#undef PG8_GLDS
#undef PG8_STAGEB
#undef PG8_ATILE
#undef PG8_LDA
#undef PG8_LDB
#undef PG8_MMA
#undef PG8_WAIT_V
#undef PG8_WAIT_L
#undef PG8_BAR
#undef PG8_SCHED
}
}

enum { EPI_IN_E = 0, EPI_UQ, EPI_UKV, EPI_OUT, EPI_IN_O };
struct EpiArgs { Bufs B; const int* pos; const float* res; float* zout; };
template <int EPI> __device__ __forceinline__ void epi_dispatch(const EpiArgs& E, int row, int col0, float* v) {
    if (EPI == EPI_IN_E) epi_inproj_even(E.B, E.pos, row, col0, v);
    else if (EPI == EPI_UQ) epi_upq(E.B, E.pos, row, col0, v, rstd_from(E.B.SSQQ, row));
    else if (EPI == EPI_UKV) epi_upkv(E.B, row, col0, v, rstd_from(E.B.SSQKV, row));
    else if (EPI == EPI_IN_O) epi_inproj_odd(E.B, E.pos, row, col0, v);
    else { const float* r = E.res + (size_t)row * DM + col0; float* z = E.zout + (size_t)row * DM + col0;
#pragma unroll
        for (int j = 0; j < 8; ++j) z[j] = DN_ALPHA * r[j] + v[j]; }
}
template <int EPI> __global__ __launch_bounds__(256) void k_gemm_naive(const bf16_t* A, int lda, const bf16_t* A2, int lda2, int K1, const bf16_t* Bt, int K, EpiArgs E) {
    __shared__ float As[32][66]; __shared__ float Bs[32][66];
    const int tid = threadIdx.x, tm = blockIdx.y * 64, tn = blockIdx.x * 64;
    const int tr = tid >> 3, tc = tid & 7;
    float acc[2][8] = {};
    const int lr = tid >> 2, lk = (tid & 3) * 8;
    for (int k0 = 0; k0 < K; k0 += 32) {
        const bf16_t* ap = (k0 < K1) ? A + (size_t)(tm + lr) * lda + k0 + lk : A2 + (size_t)(tm + lr) * lda2 + (k0 - K1) + lk;
        const u32x4 av = *(const u32x4*)ap; const u32x4 bv = *(const u32x4*)(Bt + (size_t)(tn + lr) * K + k0 + lk);
        As[lk + 0][lr] = bflo(av.x); As[lk + 1][lr] = bfhi(av.x); As[lk + 2][lr] = bflo(av.y); As[lk + 3][lr] = bfhi(av.y); As[lk + 4][lr] = bflo(av.z); As[lk + 5][lr] = bfhi(av.z); As[lk + 6][lr] = bflo(av.w); As[lk + 7][lr] = bfhi(av.w);
        Bs[lk + 0][lr] = bflo(bv.x); Bs[lk + 1][lr] = bfhi(bv.x); Bs[lk + 2][lr] = bflo(bv.y); Bs[lk + 3][lr] = bfhi(bv.y); Bs[lk + 4][lr] = bflo(bv.z); Bs[lk + 5][lr] = bfhi(bv.z); Bs[lk + 6][lr] = bflo(bv.w); Bs[lk + 7][lr] = bfhi(bv.w);
        __syncthreads();
#pragma unroll 8
        for (int kk = 0; kk < 32; ++kk) { const float a0 = As[kk][2 * tr], a1 = As[kk][2 * tr + 1];
#pragma unroll
            for (int j = 0; j < 8; ++j) { const float bb = Bs[kk][tc * 8 + j]; acc[0][j] += a0 * bb; acc[1][j] += a1 * bb; } }
        __syncthreads();
    }
    epi_dispatch<EPI>(E, tm + 2 * tr, tn + tc * 8, acc[0]); epi_dispatch<EPI>(E, tm + 2 * tr + 1, tn + tc * 8, acc[1]);
}
template <int EPI> struct FastEpi {
    EpiArgs E;
    __device__ __forceinline__ void operator()(const f32x4 (&acc)[2][2][4][2], const pg8::Unit& u, int wr, int wc, int fr, int fq) const {
        const bool ssq_tile = (EPI == EPI_IN_E) && (u.pn == C_MQ / 256 || u.pn == C_MKV / 256);
        const bool ksum_tile = (EPI == EPI_IN_O) && (u.pn >= 4 && u.pn < 8);
        float ks[2][8];
#pragma unroll
        for (int bj = 0; bj < 2; ++bj)
#pragma unroll
            for (int j = 0; j < 8; ++j) ks[bj][j] = 0.f;
#pragma unroll
        for (int ai = 0; ai < 2; ++ai)
#pragma unroll
            for (int m = 0; m < 4; ++m) {
                const int row = u.pm * 256 + ai * 128 + wr * 64 + m * 16 + fr;
                float rstd = 1.f;
                if (EPI == EPI_UQ) rstd = rstd_from(E.B.SSQQ, row);
                if (EPI == EPI_UKV) rstd = rstd_from(E.B.SSQKV, row);
                if (ssq_tile) { float s = 0.f;
#pragma unroll
                    for (int bj = 0; bj < 2; ++bj)
#pragma unroll
                        for (int n = 0; n < 2; ++n) { const f32x4 x = acc[ai][bj][m][n]; s += (x[0] * x[0] + x[1] * x[1]) + (x[2] * x[2] + x[3] * x[3]); }
                    s += __shfl_xor(s, 16); s += __shfl_xor(s, 32);
                    if (fq == 0) (u.pn == C_MQ / 256 ? E.B.SSQQ : E.B.SSQKV)[(size_t)row * 4 + wc] = s; }
#pragma unroll
                for (int bj = 0; bj < 2; ++bj) {
                    const int col0 = u.pn * 256 + bj * 128 + wc * 32 + 8 * fq;
                    float v[8];
#pragma unroll
                    for (int j = 0; j < 4; ++j) { v[j] = acc[ai][bj][m][0][j]; v[4 + j] = acc[ai][bj][m][1][j]; }
                    if (EPI == EPI_IN_E) epi_inproj_even(E.B, E.pos, row, col0, v);
                    else if (EPI == EPI_UQ) epi_upq(E.B, E.pos, row, col0, v, rstd);
                    else if (EPI == EPI_UKV) epi_upkv(E.B, row, col0, v, rstd);
                    else if (EPI == EPI_IN_O) { epi_inproj_odd(E.B, E.pos, row, col0, v);
                        if (ksum_tile) {
#pragma unroll
                            for (int j = 0; j < 8; ++j) ks[bj][j] += v[j]; } }
                    else { const float* r = E.res + (size_t)row * DM + col0; float* z = E.zout + (size_t)row * DM + col0;
                        const f32x4 r0 = *(const f32x4*)r, r1 = *(const f32x4*)(r + 4);
                        f32x4 z0, z1;
#pragma unroll
                        for (int j = 0; j < 4; ++j) { z0[j] = DN_ALPHA * r0[j] + v[j]; z1[j] = DN_ALPHA * r1[j] + v[4 + j]; }
                        *(f32x4*)z = z0; *(f32x4*)(z + 4) = z1; }
                }
            }
        if (ksum_tile) {
#pragma unroll
            for (int bj = 0; bj < 2; ++bj)
#pragma unroll
                for (int j = 0; j < 8; ++j) { float s = ks[bj][j]; s += __shfl_xor(s, 1); s += __shfl_xor(s, 2); s += __shfl_xor(s, 4); s += __shfl_xor(s, 8); ks[bj][j] = s; }
            if (fr == 0) {
#pragma unroll
                for (int bj = 0; bj < 2; ++bj) { float* d = E.B.KPART + (size_t)u.pm * 2048 + wr * 1024 + (u.pn * 256 - 1024) + bj * 128 + wc * 32 + 8 * fq;
                    *(f32x4*)d = (f32x4){ks[bj][0], ks[bj][1], ks[bj][2], ks[bj][3]}; *(f32x4*)(d + 4) = (f32x4){ks[bj][4], ks[bj][5], ks[bj][6], ks[bj][7]}; } }
        }
    }
};
template <int EPI, bool TWOSEG> __device__ __forceinline__ void gemm_run(unsigned char* lds, const pg8::Gemm& g, const EpiArgs& E, int grid, int bid) {
    pg8::StaticOrder S; S.init(g.M, g.N, grid, bid);
    FastEpi<EPI> F{E};
    pg8::gemm_phase<FastEpi<EPI>, TWOSEG>((PG8_LAS unsigned char*)lds, g, S, F);
}
template <int EPI, bool TWOSEG> __global__ __launch_bounds__(512, 2) void k_gemm_fast(pg8::Gemm g, EpiArgs E) {
    extern __shared__ __attribute__((aligned(16))) unsigned char lds[];
    gemm_run<EPI, TWOSEG>(lds, g, E, gridDim.x, blockIdx.x);
}

__device__ __forceinline__ unsigned moba_select(const float (&gate)[8], int qb) {
    unsigned mask = 0;
#pragma unroll
    for (int n = 0; n < 8; ++n) { int cnt = 0;
#pragma unroll
        for (int mm = 0; mm < 8; ++mm) cnt += (mm != n) && (mm < qb) && (gate[mm] > gate[n] || (gate[mm] == gate[n] && mm < n));
        if (n < qb && cnt < 3) mask |= 1u << n; }
    return mask;
}
namespace fa {
typedef short bf16x8 __attribute__((ext_vector_type(8)));
typedef short s16x4 __attribute__((ext_vector_type(4)));
typedef float f32x16 __attribute__((ext_vector_type(16)));
constexpr float THR = 8.f;
#define FA_SBAR() __builtin_amdgcn_sched_barrier(0)
__device__ __forceinline__ int crow(int r, int hi) { return (r & 3) + 8 * (r >> 2) + 4 * hi; }
__device__ __forceinline__ unsigned cvtpk(float lo, float hi) { unsigned r; asm volatile("v_cvt_pk_bf16_f32 %0, %1, %2" : "=v"(r) : "v"(lo), "v"(hi)); return r; }
template <int DV> __device__ __forceinline__ int v_st(int k, int c) { const int kk = (k & ~0xC) | ((k & 4) << 1) | ((k & 8) >> 1); return ((kk >> 3) * (DV / 32) + (c >> 5)) * 512 + ((kk & 7) * 32 + (c & 31)) * 2; }
__device__ __forceinline__ int v_rd_base(int lane) { return ((lane & 3) << 3) | (((lane >> 2) & 3) << 6) | (((lane >> 4) & 1) << 5) | (((lane >> 5) & 1) << 8); }
template <int DQK, int DV, bool MOBA> struct Cfg {
    static constexpr int KB = 64 * DQK * 2, VB = 64 * DV * 2, NKS = DQK / 16, NCB = DV / 32;
    static constexpr int NKC = (64 * DQK / 8) / 512, NVC = (64 * DV / 8) / 512;
    static constexpr int OFF_K = 0, OFF_V = 2 * KB, OFF_WS = 2 * KB + 2 * VB, OFF_KM = OFF_WS + 8 * 64 * 4, LDS = OFF_KM + 8 * 64 * 4;
};
struct Tens { const bf16_t* Q; int qp; const bf16_t* K1; int k1p; const bf16_t* K2; int k2p; const bf16_t* V; int vp; bf16_t* G; int gp; const float* kpart; };
template <int DQK, int DV, bool MOBA>
__device__ __forceinline__ void unit(const Tens& T, int b, int h, int qb, unsigned char* lds) {
    typedef Cfg<DQK, DV, MOBA> C;
    const int tid = threadIdx.x, wid = __builtin_amdgcn_readfirstlane(tid >> 6), lane = tid & 63, r32 = lane & 31, hi = lane >> 5;
    const size_t rb = (size_t)b * SEQ;
    const int q0 = qb * 256, qlo = q0 + wid * 32;
    unsigned char* K_lds = lds + C::OFF_K; unsigned char* V_lds = lds + C::OFF_V;
    float* ws = (float*)(lds + C::OFF_WS) + wid * 64; float* li_l = ws; float* al_l = ws + 32;
    bf16x8 qr[C::NKS];
    { const bf16_t* qrow = T.Q + (rb + qlo + r32) * T.qp;
#pragma unroll
      for (int d0 = 0; d0 < C::NKS; ++d0) qr[d0] = *(const bf16x8*)(qrow + d0 * 16 + hi * 8); }
    unsigned selmask = 0xffu;
    if (MOBA) {
        float* km = (float*)(lds + C::OFF_KM);
        { const int n = tid >> 6, c = tid & 63; const float* kp = T.kpart + (size_t)(b * 8 + n) * 2048 + h * 64 + c; km[n * 64 + c] = (n < qb) ? (kp[0] + kp[1024]) * (1.f / 256.f) : 0.f; }
        __syncthreads();
        if (qb >= 4) {
            float gate[8];
#pragma unroll
            for (int n = 0; n < 8; ++n) { float g = 0.f;
#pragma unroll
                for (int d0 = 0; d0 < C::NKS; ++d0)
#pragma unroll
                    for (int j = 0; j < 8; ++j) g += bf2f((bf16_t)qr[d0][j]) * km[n * 64 + d0 * 16 + hi * 8 + j];
                { auto rr = __builtin_amdgcn_permlane32_swap(__float_as_uint(g), __float_as_uint(g), false, false); g = __uint_as_float(rr[0]) + __uint_as_float(rr[1]); }
                gate[n] = g; }
            selmask = moba_select(gate, qb);
        }
    }
    const int NT = 4 * qb + 4;
    constexpr int NS = DQK / 64, NVP = C::NCB / 2 * 8 / 8;
    unsigned koff[NS], voff[NVP];
    { const int row = 8 * wid + (lane >> 3), c = (lane & 7) ^ (lane >> 3);
#pragma unroll
      for (int sidx = 0; sidx < NS; ++sidx) koff[sidx] = (DQK == 192 && sidx == 2) ? (unsigned)(row * T.k2p + c * 8) * 2u : (unsigned)(row * T.k1p + sidx * 64 + c * 8) * 2u;
#pragma unroll
      for (int i = 0; i < NVP; ++i) { const int q = wid + 8 * i, kg = q / (C::NCB / 2), j = q % (C::NCB / 2), cb = 2 * j + (lane >> 5), kk = kg * 8 + ((lane >> 2) & 7);
          const int key = (kk & ~0xC) | ((kk & 4) << 1) | ((kk & 8) >> 1); voff[i] = (unsigned)(key * T.vp + cb * 32 + (lane & 3) * 8) * 2u; } }
    const char* k1b = (const char*)(T.K1 + rb * T.k1p); const char* k2b = (DQK == 192) ? (const char*)(T.K2 + rb * T.k2p) : nullptr; const char* vbs = (const char*)(T.V + rb * T.vp);
    typedef __attribute__((address_space(3))) unsigned lds_u32;
#define FA_DMA(t, buf) do { const char* k1t = k1b + (size_t)(t) * 128 * T.k1p; const char* vt = vbs + (size_t)(t) * 128 * T.vp; \
        _Pragma("unroll") for (int sidx = 0; sidx < NS; ++sidx) { const char* src = (DQK == 192 && sidx == 2) ? k2b + (size_t)(t) * 128 * T.k2p : k1t; \
            __builtin_amdgcn_global_load_lds((const unsigned*)(src + koff[sidx]), (lds_u32*)(K_lds + (buf) * C::KB + sidx * 8192 + wid * 1024), 16, 0, 0); } \
        _Pragma("unroll") for (int i = 0; i < NVP; ++i) __builtin_amdgcn_global_load_lds((const unsigned*)(vt + voff[i]), (lds_u32*)(V_lds + (buf) * C::VB + (wid + 8 * i) * 1024), 16, 0, 0); } while (0)
    FA_DMA(0, 0);
    asm volatile("s_waitcnt vmcnt(0)" ::: "memory");
    __syncthreads();
    float m_reg = -1e30f, l_reg = 0.f; f32x16 o[C::NCB];
#pragma unroll
    for (int d = 0; d < C::NCB; ++d) o[d] = f32x16{};
    const int vb0 = (int)(uintptr_t)V_lds + v_rd_base(lane);
    int kb[4];
#pragma unroll
    for (int dd = 0; dd < 4; ++dd) kb[dd] = r32 * 128 + (((2 * dd + hi) ^ (r32 & 7)) << 4);
    const float NEG = -__builtin_inff();
    for (int t = 0; t < NT; ++t) {
        const int cur = t & 1;
        const bool act = 64 * t <= qlo + 31;
        if (t + 1 < NT) FA_DMA(t + 1, cur ^ 1);
        f32x16 p0, p1;
        if (act) {
            p0 = f32x16{}; p1 = f32x16{};
            const unsigned char* kt = K_lds + cur * C::KB;
#pragma unroll
            for (int d0 = 0; d0 < C::NKS; ++d0) { const unsigned char* a = kt + kb[d0 & 3] + (d0 >> 2) * 8192;
                const bf16x8 b0 = *(const bf16x8*)a, b1 = *(const bf16x8*)(a + 32 * 128);
                p0 = __builtin_amdgcn_mfma_f32_32x32x16_bf16(b0, qr[d0], p0, 0, 0, 0);
                p1 = __builtin_amdgcn_mfma_f32_32x32x16_bf16(b1, qr[d0], p1, 0, 0, 0); }
        }
        if (act) {
            if (64 * t + 63 > qlo) {
                const int dq = qlo + r32 - 64 * t - 4 * hi;
#pragma unroll
                for (int r = 0; r < 16; ++r) { const int c = (r & 3) + 8 * (r >> 2); if (c > dq) p0[r] = NEG; if (c + 32 > dq) p1[r] = NEG; }
            }
            if (MOBA && qb >= 4 && t < 4 * qb) {
                if (!((selmask >> (t >> 2)) & 1u)) {
#pragma unroll
                    for (int r = 0; r < 16; ++r) { p0[r] = NEG; p1[r] = NEG; } }
            }
            float pmax = p0[0];
#pragma unroll
            for (int r = 1; r < 16; ++r) pmax = fmaxf(pmax, p0[r]);
#pragma unroll
            for (int r = 0; r < 16; ++r) pmax = fmaxf(pmax, p1[r]);
            { auto rr = __builtin_amdgcn_permlane32_swap(__float_as_uint(pmax), __float_as_uint(pmax), false, false); pmax = fmaxf(__uint_as_float(rr[0]), __uint_as_float(rr[1])); }
            float mn, alpha;
            if (__all(pmax - m_reg <= THR)) { mn = m_reg; alpha = 1.f; }
            else { mn = fmaxf(m_reg, pmax); alpha = __builtin_amdgcn_exp2f(m_reg - mn); m_reg = mn; }
#pragma unroll
            for (int r = 0; r < 16; ++r) { p0[r] = __builtin_amdgcn_exp2f(p0[r] - mn); p1[r] = __builtin_amdgcn_exp2f(p1[r] - mn); }
            float ps = 0.f;
#pragma unroll
            for (int r = 0; r < 16; ++r) ps += p0[r] + p1[r];
            { auto rr = __builtin_amdgcn_permlane32_swap(__float_as_uint(ps), __float_as_uint(ps), false, false); ps = __uint_as_float(rr[0]) + __uint_as_float(rr[1]); }
            l_reg = l_reg * alpha + ps;
            if (__any(alpha < 1.f)) { if (hi == 0) al_l[r32] = alpha; asm volatile("s_waitcnt lgkmcnt(0)" ::: "memory");
#pragma unroll
                for (int r = 0; r < 16; ++r) { const float a = al_l[crow(r, hi)];
#pragma unroll
                    for (int d = 0; d < C::NCB; ++d) o[d][r] *= a; } }
            bf16x8 pa0, pa1, pa2, pa3;
#define FA_PK4(P, B_, OUT) do { unsigned a0 = cvtpk(P[B_ + 0], P[B_ + 1]), a1 = cvtpk(P[B_ + 2], P[B_ + 3]); unsigned b0 = cvtpk(P[B_ + 4], P[B_ + 5]), b1 = cvtpk(P[B_ + 6], P[B_ + 7]); \
        auto r0 = __builtin_amdgcn_permlane32_swap(a0, b0, false, false); auto r1 = __builtin_amdgcn_permlane32_swap(a1, b1, false, false); \
        u32x4 w = {r0[0], r1[0], r0[1], r1[1]}; OUT = __builtin_bit_cast(bf16x8, w); } while (0)
            FA_PK4(p0, 0, pa0); FA_PK4(p0, 8, pa1); FA_PK4(p1, 0, pa2); FA_PK4(p1, 8, pa3);
#undef FA_PK4
            const int vb = vb0 + cur * C::VB;
#define FA_TRRD(dst, off) asm volatile("ds_read_b64_tr_b16 %0, %1 offset:%2" : "=&v"(dst) : "v"(vb), "i"(off) : "memory")
#pragma unroll
            for (int d0 = 0; d0 < C::NCB; ++d0) {
                s16x4 l0, l1, l2, l3, h0, h1, h2, h3; constexpr int KS = 2 * C::NCB * 512, HF = C::NCB * 512;
                FA_TRRD(l0, d0 * 512); FA_TRRD(h0, d0 * 512 + HF); FA_TRRD(l1, d0 * 512 + KS); FA_TRRD(h1, d0 * 512 + KS + HF);
                FA_TRRD(l2, d0 * 512 + 2 * KS); FA_TRRD(h2, d0 * 512 + 2 * KS + HF); FA_TRRD(l3, d0 * 512 + 3 * KS); FA_TRRD(h3, d0 * 512 + 3 * KS + HF);
                asm volatile("s_waitcnt lgkmcnt(0)" ::: "memory"); FA_SBAR();
                o[d0] = __builtin_amdgcn_mfma_f32_32x32x16_bf16(pa0, (bf16x8){l0[0], l0[1], l0[2], l0[3], h0[0], h0[1], h0[2], h0[3]}, o[d0], 0, 0, 0);
                o[d0] = __builtin_amdgcn_mfma_f32_32x32x16_bf16(pa1, (bf16x8){l1[0], l1[1], l1[2], l1[3], h1[0], h1[1], h1[2], h1[3]}, o[d0], 0, 0, 0);
                o[d0] = __builtin_amdgcn_mfma_f32_32x32x16_bf16(pa2, (bf16x8){l2[0], l2[1], l2[2], l2[3], h2[0], h2[1], h2[2], h2[3]}, o[d0], 0, 0, 0);
                o[d0] = __builtin_amdgcn_mfma_f32_32x32x16_bf16(pa3, (bf16x8){l3[0], l3[1], l3[2], l3[3], h3[0], h3[1], h3[2], h3[3]}, o[d0], 0, 0, 0);
            }
#undef FA_TRRD
        }
        asm volatile("s_waitcnt vmcnt(0)" ::: "memory");
        __syncthreads();
    }
#undef FA_DMA
    if (hi == 0) li_l[r32] = l_reg;
    asm volatile("s_waitcnt lgkmcnt(0)" ::: "memory");
    bf16_t* gw = T.G + (rb + qlo) * T.gp;
#pragma unroll
    for (int r = 0; r < 16; ++r) { const int orow = crow(r, hi); const float rl = __builtin_amdgcn_rcpf(li_l[orow]);
#pragma unroll
        for (int d0 = 0; d0 < C::NCB; ++d0) { bf16_t* gp = gw + (size_t)orow * T.gp + d0 * 32 + r32; *gp = (bf16_t)f2bf(o[d0][r] * rl * bf2f(*gp)); } }
    __syncthreads();
}
template <int DQK, int DV, bool MOBA, int NH>
__device__ __forceinline__ void phase(const Tens& T0, int hq, int hk, int hv, int hg, unsigned char* lds, int grid, int bid) {
    const int nitems = NB * NH * 4;
    for (int it = bid; it < nitems; it += grid) {
        const int p = it & 3, bh = it >> 2, b = bh / NH, h = bh % NH;
        Tens T = T0; T.Q += h * hq; T.K1 += h * hk; T.V += h * hv; T.G += h * hg;
        unit<DQK, DV, MOBA>(T, b, h, 7 - p, lds);
        unit<DQK, DV, MOBA>(T, b, h, p, lds);
    }
}
#undef FA_SBAR
}
constexpr int LDS_MLA = fa::Cfg<192, 128, false>::LDS, LDS_MOBA = fa::Cfg<64, 64, true>::LDS;
template <int WHICH> __global__ __launch_bounds__(512, 2) void k_attn_fast(Bufs B) {
    extern __shared__ __attribute__((aligned(16))) unsigned char lds[];
    if (WHICH == 0) { fa::Tens T{B.QM, 1536, B.KN, 1024, B.KPE, 64, B.VM, 1024, B.GM, 1024, nullptr}; fa::phase<192, 128, false, 8>(T, 192, 128, 128, 128, lds, gridDim.x, blockIdx.x); }
    else { fa::Tens T{B.QB, 1024, B.KB, 1024, nullptr, 0, B.VB, 1024, B.GB, 1024, B.KPART}; fa::phase<64, 64, true, 16>(T, 64, 64, 64, 64, lds, gridDim.x, blockIdx.x); }
}

namespace ret {
typedef short bf16x8 __attribute__((ext_vector_type(8)));
typedef short v4i16 __attribute__((ext_vector_type(4)));
typedef float f32x16 __attribute__((ext_vector_type(16)));
#define RLAS __attribute__((address_space(3)))
typedef RLAS unsigned char lds_b;
constexpr int OFF_Q = 0, OFF_K = 32768, OFF_V = 65536, OFF_R = 81920, LDS = 114688;
__device__ __forceinline__ int crow(int r, int hi) { return (r & 3) + 8 * (r >> 2) + 4 * hi; }
__device__ __forceinline__ unsigned off_b(unsigned row, unsigned ch) { return 256u * row + 16u * (ch ^ (((row & 3) << 2) | ((row >> 2) & 3))); }
__device__ __forceinline__ bf16x8 rowfrag(lds_b* img, unsigned row, unsigned ch) { return *(RLAS bf16x8*)(img + off_b(row, ch)); }
__device__ __forceinline__ v4i16 trrd(lds_b* p) { return __builtin_amdgcn_ds_read_tr16_b64_v4i16((RLAS v4i16*)p); }
__device__ __forceinline__ bf16x8 trfrag_b(lds_b* img, int lane, int c, int ks) {
    const unsigned h = lane >> 5, blk = (lane >> 4) & 1, q = (lane & 15) >> 2, p = lane & 3;
    const v4i16 t0 = trrd(img + off_b(16 * ks + 8 * h + q, 4 * c + 2 * blk + (p >> 1)) + 8 * (p & 1));
    const v4i16 t1 = trrd(img + off_b(16 * ks + 8 * h + 4 + q, 4 * c + 2 * blk + (p >> 1)) + 8 * (p & 1));
    return (bf16x8){t0[0], t0[1], t0[2], t0[3], t1[0], t1[1], t1[2], t1[3]};
}
__device__ __forceinline__ unsigned off_v(unsigned row, unsigned colbyte) { return 128u * row + (colbyte ^ (((row >> 1) & 1) << 6)); }
__device__ __forceinline__ bf16x8 trfrag_v(lds_b* img, int lane, int c, int ks) {
    const unsigned h = lane >> 5, blk = (lane >> 4) & 1, q = (lane & 15) >> 2, p = lane & 3;
    const v4i16 t0 = trrd(img + off_v(16 * ks + 8 * h + q, 64 * c + 32 * blk + 8 * p));
    const v4i16 t1 = trrd(img + off_v(16 * ks + 8 * h + 4 + q, 64 * c + 32 * blk + 8 * p));
    return (bf16x8){t0[0], t0[1], t0[2], t0[3], t1[0], t1[1], t1[2], t1[3]};
}
__device__ __forceinline__ void unit(const Bufs& B, int b, int h, int ds, unsigned char* lds_g) {
    lds_b* lds = (lds_b*)lds_g;
    const int tid = threadIdx.x, wid = __builtin_amdgcn_readfirstlane(tid >> 6), lane = tid & 63, r32 = lane & 31, hi = lane >> 5;
    const int ib = wid & 3, jb0 = 2 * (wid >> 2), db = wid >> 2, cb = wid & 3;
    lds_b* QI = lds + OFF_Q; lds_b* KI = lds + OFF_K; lds_b* VI = lds + OFF_V; lds_b* RI = lds + OFF_R;
    f32x16 R0 = f32x16{}, R1 = f32x16{};
    { const u32x4 z = {0u, 0u, 0u, 0u};
#pragma unroll
      for (int k = 0; k < 4; ++k) *(RLAS u32x4*)(RI + tid * 64 + 16 * k) = z; }
    const unsigned qk_off = (unsigned)((4 * wid + (lane >> 4)) * 1024 + (((lane & 15) ^ (((lane >> 4) << 2) | (wid & 3))) * 8)) * 2u;
    const unsigned v_off = (unsigned)((8 * wid + (lane >> 3)) * 2048 + (((lane & 7) ^ (((lane >> 4) & 1) << 2)) * 8)) * 2u;
    const float gC = exp2f(128.0f * gamma_log2(h));
    typedef RLAS unsigned lds_u32;
    for (int n = 0; n < 16; ++n) {
        const size_t row0 = (size_t)b * SEQ + 128 * n;
        f32x16 S0 = f32x16{}, S1 = f32x16{}, O = f32x16{};
#pragma unroll
        for (int ct = 0; ct < 2; ++ct) {
            const char* qs = (const char*)(B.QR + row0 * 1024 + 256 * h + 128 * ct); const char* ks_ = (const char*)(B.KR + row0 * 1024 + 256 * h + 128 * ct);
#pragma unroll
            for (int i = 0; i < 4; ++i) {
                __builtin_amdgcn_global_load_lds((const unsigned*)(qs + qk_off + (size_t)i * 65536), (lds_u32*)(QI + (wid + 8 * i) * 1024), 16, 0, 0);
                __builtin_amdgcn_global_load_lds((const unsigned*)(ks_ + qk_off + (size_t)i * 65536), (lds_u32*)(KI + (wid + 8 * i) * 1024), 16, 0, 0); }
            if (ct == 0) { const char* vs = (const char*)(B.VR + row0 * 2048 + 512 * h + 64 * ds);
#pragma unroll
                for (int i = 0; i < 2; ++i) __builtin_amdgcn_global_load_lds((const unsigned*)(vs + v_off + (size_t)i * 262144), (lds_u32*)(VI + (wid + 8 * i) * 1024), 16, 0, 0); }
            asm volatile("s_waitcnt vmcnt(0)" ::: "memory");
            __syncthreads();
            lds_b* RIc = RI + ct * 16384;
#pragma unroll
            for (int s = 0; s < 8; ++s) {
                const bf16x8 bq = rowfrag(QI, 32 * ib + r32, 2 * s + hi);
                if (jb0 <= ib) S0 = __builtin_amdgcn_mfma_f32_32x32x16_bf16(rowfrag(KI, 32 * jb0 + r32, 2 * s + hi), bq, S0, 0, 0, 0);
                if (jb0 + 1 <= ib) S1 = __builtin_amdgcn_mfma_f32_32x32x16_bf16(rowfrag(KI, 32 * (jb0 + 1) + r32, 2 * s + hi), bq, S1, 0, 0, 0);
                O = __builtin_amdgcn_mfma_f32_32x32x16_bf16(rowfrag(RIc, 32 * db + r32, 2 * s + hi), bq, O, 0, 0, 0);
            }
#pragma unroll
            for (int ks = 0; ks < 8; ++ks) {
                const bf16x8 a = trfrag_b(KI, lane, cb, ks), bv = trfrag_v(VI, lane, db, ks);
                if (ct == 0) R0 = __builtin_amdgcn_mfma_f32_32x32x16_bf16(a, bv, R0, 0, 0, 0); else R1 = __builtin_amdgcn_mfma_f32_32x32x16_bf16(a, bv, R1, 0, 0, 0);
            }
            __syncthreads();
        }
#pragma unroll
        for (int tI = 0; tI < 2; ++tI) { const int jb = jb0 + tI;
            if (jb <= ib) { const f32x16& S = tI ? S1 : S0;
#pragma unroll
                for (int g = 0; g < 4; ++g) { float v[4];
#pragma unroll
                    for (int e = 0; e < 4; ++e) { const int jl = 32 * jb + 8 * g + 4 * hi + e; v[e] = (jl <= 32 * ib + r32) ? S[4 * g + e] : 0.f; }
                    u32x2 w; w.x = pk2(v[0], v[1]); w.y = pk2(v[2], v[3]);
                    *(RLAS u32x2*)(QI + off_b(32 * ib + r32, 4 * jb + g) + 8 * hi) = w; } } }
        __syncthreads();
        for (int s = 0; s < 2 * (ib + 1); ++s) O = __builtin_amdgcn_mfma_f32_32x32x16_bf16(trfrag_v(VI, lane, db, s), rowfrag(QI, 32 * ib + r32, 2 * s + hi), O, 0, 0, 0);
        { bf16_t* op = B.VR + (row0 + 32 * ib + r32) * 2048 + 512 * h + 64 * ds + 32 * db + 4 * hi;
#pragma unroll
          for (int g = 0; g < 4; ++g) { u32x2 w; w.x = pk2(O[4 * g], O[4 * g + 1]); w.y = pk2(O[4 * g + 2], O[4 * g + 3]); *(u32x2*)(op + 8 * g) = w; } }
        R0 = R0 * gC; R1 = R1 * gC;
#pragma unroll
        for (int g = 0; g < 4; ++g) { u32x2 w0, w1; w0.x = pk2(R0[4 * g], R0[4 * g + 1]); w0.y = pk2(R0[4 * g + 2], R0[4 * g + 3]); w1.x = pk2(R1[4 * g], R1[4 * g + 1]); w1.y = pk2(R1[4 * g + 2], R1[4 * g + 3]);
            *(RLAS u32x2*)(RI + off_b(32 * db + r32, 4 * cb + g) + 8 * hi) = w0; *(RLAS u32x2*)(RI + 16384 + off_b(32 * db + r32, 4 * cb + g) + 8 * hi) = w1; }
        __syncthreads();
    }
}
__device__ __forceinline__ void phase(const Bufs& B, unsigned char* lds, int grid, int bid) {
    for (int u = bid; u < 256; u += grid) { const int xcd = u & 7, idx = u >> 3, pair = xcd * 4 + (idx >> 3), ds = idx & 7; unit(B, pair >> 2, pair & 3, ds, lds); }
}
__device__ __forceinline__ void normgate_phase(const Bufs& B, int gw, int ngw, int lane) {
    for (int it = gw; it < MT * 4; it += ngw) { const int row = it >> 2, h = it & 3;
        const u32x4 ow = *(const u32x4*)(B.VR + (size_t)row * 2048 + h * 512 + lane * 8);
        float a[8] = {bflo(ow.x), bfhi(ow.x), bflo(ow.y), bfhi(ow.y), bflo(ow.z), bfhi(ow.z), bflo(ow.w), bfhi(ow.w)};
        float s = 0.f;
#pragma unroll
        for (int j = 0; j < 8; ++j) s += a[j];
        const float mean = wave_sum(s) * (1.f / 512.f); float s2 = 0.f;
#pragma unroll
        for (int j = 0; j < 8; ++j) { a[j] -= mean; s2 += a[j] * a[j]; }
        const float rstd = 1.f / sqrtf(wave_sum(s2) * (1.f / 512.f) + LN_EPS);
        bf16_t* gp = B.GR + (size_t)row * 2048 + h * 512 + lane * 8; const u32x4 gwd = *(const u32x4*)gp;
        const float g[8] = {bflo(gwd.x), bfhi(gwd.x), bflo(gwd.y), bfhi(gwd.y), bflo(gwd.z), bfhi(gwd.z), bflo(gwd.w), bfhi(gwd.w)};
        float o[8];
#pragma unroll
        for (int j = 0; j < 8; ++j) o[j] = a[j] * rstd * g[j];
        store8bf(gp, o); }
}
#undef RLAS
}
__global__ __launch_bounds__(512, 2) void k_ret_fast(Bufs B) {
    extern __shared__ __attribute__((aligned(16))) unsigned char lds[];
    ret::phase(B, lds, gridDim.x, blockIdx.x);
}
__global__ __launch_bounds__(512) void k_normgate(Bufs B) { ret::normgate_phase(B, blockIdx.x * 8 + (threadIdx.x >> 6), gridDim.x * 8, threadIdx.x & 63); }

__global__ __launch_bounds__(256) void k_ssq_naive(Bufs B) {
    const int wave = threadIdx.x >> 6, lane = threadIdx.x & 63; const int m = blockIdx.x * 4 + wave;
    for (int t = 0; t < 2; ++t) { const bf16_t* src = (t ? B.MKV : B.MQ) + (size_t)m * 256 + lane * 4; float s = 0.f;
        for (int j = 0; j < 4; ++j) { const float v = bf2f(src[j]); s += v * v; } s = wave_sum(s);
        if (lane == 0) { float* d = (t ? B.SSQKV : B.SSQQ) + (size_t)m * 4; d[0] = s; d[1] = 0.f; d[2] = 0.f; d[3] = 0.f; } }
}
__global__ __launch_bounds__(256) void k_kpart_naive(Bufs B) {
    const int pb = blockIdx.x;
    for (int c = threadIdx.x; c < 1024; c += 256) { float s = 0.f; for (int r = 0; r < 256; ++r) s += bf2f(B.KB[(size_t)(pb * 256 + r) * 1024 + c]); B.KPART[(size_t)pb * 2048 + c] = s; B.KPART[(size_t)pb * 2048 + 1024 + c] = 0.f; }
}

__global__ __launch_bounds__(256) void k_ret_naive(Bufs B) {
    const int wave = threadIdx.x >> 6, lane = threadIdx.x & 63; const int gwv = blockIdx.x * 4 + wave; const int row = gwv >> 2, h = gwv & 3;
    const int b0 = (row / SEQ) * SEQ, ni = (row - b0) >> 7;
    float q[4]; { const u32x2 w = *(const u32x2*)(B.QR + (size_t)row * 1024 + h * 256 + lane * 4); q[0] = bflo(w.x); q[1] = bfhi(w.x); q[2] = bflo(w.y); q[3] = bfhi(w.y); }
    float acc[8] = {}; const float gC = 128.0f * gamma_log2(h);
    for (int j = b0; j <= row; ++j) {
        const u32x2 kw = *(const u32x2*)(B.KR + (size_t)j * 1024 + h * 256 + lane * 4);
        float d = q[0] * bflo(kw.x) + q[1] * bfhi(kw.x) + q[2] * bflo(kw.y) + q[3] * bfhi(kw.y); d = wave_sum(d);
        const int nj = (j - b0) >> 7; const float w = d * exp2f(gC * (float)(ni - nj));
        const float pw = bf2f((bf16_t)f2bf(w));
        const u32x4 vv = *(const u32x4*)(B.VR + (size_t)j * 2048 + h * 512 + lane * 8);
        acc[0] += pw * bflo(vv.x); acc[1] += pw * bfhi(vv.x); acc[2] += pw * bflo(vv.y); acc[3] += pw * bfhi(vv.y); acc[4] += pw * bflo(vv.z); acc[5] += pw * bfhi(vv.z); acc[6] += pw * bflo(vv.w); acc[7] += pw * bfhi(vv.w);
    }
    float s = 0.f; for (int j = 0; j < 8; ++j) s += acc[j]; const float mean = wave_sum(s) * (1.f / 512.f);
    float s2 = 0.f; for (int j = 0; j < 8; ++j) { acc[j] -= mean; s2 += acc[j] * acc[j]; } const float rstd = 1.f / sqrtf(wave_sum(s2) * (1.f / 512.f) + LN_EPS);
    bf16_t* gp = B.GR + (size_t)row * 2048 + h * 512 + lane * 8; const u32x4 gw = *(const u32x4*)gp;
    float o[8]; o[0] = acc[0] * rstd * bflo(gw.x); o[1] = acc[1] * rstd * bfhi(gw.x); o[2] = acc[2] * rstd * bflo(gw.y); o[3] = acc[3] * rstd * bfhi(gw.y);
    o[4] = acc[4] * rstd * bflo(gw.z); o[5] = acc[5] * rstd * bfhi(gw.z); o[6] = acc[6] * rstd * bflo(gw.w); o[7] = acc[7] * rstd * bfhi(gw.w);
    store8bf(gp, o);
}
__global__ __launch_bounds__(256) void k_mla_naive(Bufs B) {
    const int wave = threadIdx.x >> 6, lane = threadIdx.x & 63; const int gwv = blockIdx.x * 4 + wave; const int row = gwv >> 3, hd = gwv & 7;
    const int b0 = (row / SEQ) * SEQ;
    const bf16_t* qp = B.QM + (size_t)row * 1536 + hd * 192; const float q0 = bf2f(qp[lane]), q1 = bf2f(qp[64 + lane]), q2 = bf2f(qp[128 + lane]);
    float m = -1e30f, l = 0.f, a0 = 0.f, a1 = 0.f;
    for (int j = b0; j <= row; ++j) {
        const bf16_t* kn = B.KN + (size_t)j * 1024 + hd * 128; float d = q0 * bf2f(kn[lane]) + q1 * bf2f(kn[64 + lane]) + q2 * bf2f(B.KPE[(size_t)j * 64 + lane]); d = wave_sum(d);
        const float mn = fmaxf(m, d), al = exp2f(m - mn), pe = exp2f(d - mn); m = mn;
        const unsigned vw = *(const unsigned*)(B.VM + (size_t)j * 1024 + hd * 128 + lane * 2); const float pb = bf2f((bf16_t)f2bf(pe));
        l = l * al + pe; a0 = a0 * al + pb * bflo(vw); a1 = a1 * al + pb * bfhi(vw);
    }
    bf16_t* gp = B.GM + (size_t)row * 1024 + hd * 128 + lane * 2; const unsigned gw = *(const unsigned*)gp;
    *(unsigned*)gp = pk2(a0 / l * bflo(gw), a1 / l * bfhi(gw));
}
__global__ __launch_bounds__(256) void k_moba_naive(Bufs B) {
    const int wave = threadIdx.x >> 6, lane = threadIdx.x & 63; const int gwv = blockIdx.x * 4 + wave; const int row = gwv >> 4, h = gwv & 15;
    const int b = row / SEQ, b0 = b * SEQ, s = row - b0, qb = s >> 8;
    const float q = bf2f(B.QB[(size_t)row * 1024 + h * 64 + lane]);
    float gate[8];
#pragma unroll
    for (int n = 0; n < 8; ++n) { float g = 0.f; if (n < qb) { const float* kp = B.KPART + (size_t)(b * 8 + n) * 2048 + h * 64 + lane; g = wave_sum(q * (kp[0] + kp[1024]) * (1.f / 256.f)); } gate[n] = g; }
    const unsigned mask = moba_select(gate, qb) | (1u << qb);
    float m = -1e30f, l = 0.f, a = 0.f;
    for (int n = 0; n <= qb; ++n) { if (!((mask >> n) & 1)) continue;
        const int j1 = (n == qb) ? row : b0 + n * 256 + 255;
        for (int j = b0 + n * 256; j <= j1; ++j) {
            float d = wave_sum(q * bf2f(B.KB[(size_t)j * 1024 + h * 64 + lane]));
            const float mn = fmaxf(m, d), al = exp2f(m - mn), pe = exp2f(d - mn); m = mn; const float pb = bf2f((bf16_t)f2bf(pe));
            l = l * al + pe; a = a * al + pb * bf2f(B.VB[(size_t)j * 1024 + h * 64 + lane]);
        } }
    bf16_t* gp = B.GB + (size_t)row * 1024 + h * 64 + lane; *gp = (bf16_t)f2bf(a / l * bf2f(*gp));
}

#if DIAG
__global__ void k_diag_copy(const u32x4* a, u32x4* b, size_t n16) { for (size_t i = blockIdx.x * (size_t)blockDim.x + threadIdx.x; i < n16; i += (size_t)gridDim.x * blockDim.x) b[i] = a[i]; }
__global__ void k_diag_cmp(const bf16_t* a, const bf16_t* b, size_t n, unsigned* res) {
    float md = 0.f, ma = 0.f;
    for (size_t i = blockIdx.x * (size_t)blockDim.x + threadIdx.x; i < n; i += (size_t)gridDim.x * blockDim.x) { const float x = bf2f(a[i]), y = bf2f(b[i]); md = fmaxf(md, fabsf(x - y)); ma = fmaxf(ma, fabsf(x)); }
    atomicMax(res, __float_as_uint(md)); atomicMax(res + 1, __float_as_uint(ma));
}
__global__ void k_diag_out(float* out, const unsigned* res) { out[0] = 1e5f * __uint_as_float(res[0]) / __uint_as_float(res[1]); }
#endif
extern "C" void kernel_launch(void* const* d_in, const int* in_sizes, int n_in, void* d_out, int out_size, void* d_ws, size_t ws_size, hipStream_t stream) {
    if (n_in != 12 || out_size != MT * DM || ws_size < WS_END) { fprintf(stderr, "kernel_launch: unexpected shapes (n_in %d out %d ws %zu)\n", n_in, out_size, ws_size); return; }
    Params p{};
    p.x = (const float*)d_in[0]; p.pos = (const int*)d_in[1]; p.w_in_e = (const float*)d_in[2]; p.qn_g = (const float*)d_in[3]; p.w_uq = (const float*)d_in[4]; p.kvn_g = (const float*)d_in[5];
    p.w_ukv = (const float*)d_in[6]; p.w_out_e = (const float*)d_in[7]; p.w_in_o = (const float*)d_in[8]; p.w_out_o = (const float*)d_in[9]; p.ln_g = (const float*)d_in[10]; p.ln_b = (const float*)d_in[11];
    p.out = (float*)d_out; p.ws = (unsigned char*)d_ws;
    const Bufs B = make_bufs(p);
    static bool attr = false;
    if (!attr) { attr = true; (void)hipFuncSetAttribute((const void*)k_prologue, hipFuncAttributeMaxDynamicSharedMemorySize, 8 * 64 * 33 * 4);
        (void)hipFuncSetAttribute((const void*)k_ret_fast, hipFuncAttributeMaxDynamicSharedMemorySize, ret::LDS);
        (void)hipFuncSetAttribute((const void*)k_attn_fast<0>, hipFuncAttributeMaxDynamicSharedMemorySize, LDS_MLA);
        (void)hipFuncSetAttribute((const void*)k_attn_fast<1>, hipFuncAttributeMaxDynamicSharedMemorySize, LDS_MOBA);
#if FAST_GEMM
        (void)hipFuncSetAttribute((const void*)k_gemm_fast<EPI_IN_E, false>, hipFuncAttributeMaxDynamicSharedMemorySize, pg8::STAGE_BYTES);
        (void)hipFuncSetAttribute((const void*)k_gemm_fast<EPI_UQ, false>, hipFuncAttributeMaxDynamicSharedMemorySize, pg8::STAGE_BYTES);
        (void)hipFuncSetAttribute((const void*)k_gemm_fast<EPI_UKV, false>, hipFuncAttributeMaxDynamicSharedMemorySize, pg8::STAGE_BYTES);
        (void)hipFuncSetAttribute((const void*)k_gemm_fast<EPI_OUT, true>, hipFuncAttributeMaxDynamicSharedMemorySize, pg8::STAGE_BYTES);
        (void)hipFuncSetAttribute((const void*)k_gemm_fast<EPI_OUT, false>, hipFuncAttributeMaxDynamicSharedMemorySize, pg8::STAGE_BYTES);
        (void)hipFuncSetAttribute((const void*)k_gemm_fast<EPI_IN_O, false>, hipFuncAttributeMaxDynamicSharedMemorySize, pg8::STAGE_BYTES);
#endif
    }
    (void)hipMemsetAsync(p.ws + WS_CTL, 0, 1 * MiB, stream);
    k_prologue<<<1024, 512, 8 * 64 * 33 * 4, stream>>>(p);
    EpiArgs E{}; E.B = B; E.pos = p.pos;
#if FAST_GEMM
#define GEMM(EPI, TS, A1_, lda1_, A2_, lda2_, nt1_, Bt_, N_, K_) do { pg8::Gemm g{}; g.A1 = A1_; g.lda1 = lda1_; g.A2 = A2_; g.lda2 = lda2_; g.nt1 = nt1_; g.Bt = Bt_; g.M = MT; g.N = N_; g.K = K_; \
        hipLaunchKernelGGL((k_gemm_fast<EPI, TS>), dim3(256), dim3(512), pg8::STAGE_BYTES, stream, g, E); } while (0)
#else
#define GEMM(EPI, TS, A1_, lda1_, A2_, lda2_, nt1_, Bt_, N_, K_) hipLaunchKernelGGL((k_gemm_naive<EPI>), dim3((N_) / 64, MT / 64), dim3(256), 0, stream, A1_, lda1_, A2_, lda2_, (nt1_) * 64, Bt_, K_, E)
#endif
    GEMM(EPI_IN_E, false, B.XB, 1024, B.XB, 1024, 1 << 20, B.W1t, N1, 1024);
#if !FAST_GEMM
    k_ssq_naive<<<MT / 4, 256, 0, stream>>>(B);
#endif
#if FAST_RET
    hipLaunchKernelGGL(k_ret_fast, dim3(256), dim3(512), ret::LDS, stream, B);
    k_normgate<<<1024, 512, 0, stream>>>(B);
#else
    k_ret_naive<<<MT * 4 / 4, 256, 0, stream>>>(B);
#endif
    GEMM(EPI_UQ, false, B.MQ, 256, B.MQ, 256, 1 << 20, B.Wuqt, 1536, 256);
    GEMM(EPI_UKV, false, B.MKV, 256, B.MKV, 256, 1 << 20, B.Wukvt, 2048, 256);
#if DIAG == 1
    k_diag_copy<<<2048, 256, 0, stream>>>((const u32x4*)B.GM, (u32x4*)B.KR, (size_t)MT * 1024 * 2 / 16);
    { Bufs B2 = B; B2.GM = B.KR; k_mla_naive<<<MT * 8 / 4, 256, 0, stream>>>(B2); }
#endif
#if FAST_ATTN
    hipLaunchKernelGGL((k_attn_fast<0>), dim3(256), dim3(512), LDS_MLA, stream, B);
#else
    k_mla_naive<<<MT * 8 / 4, 256, 0, stream>>>(B);
#endif
#if DIAG == 1
    k_diag_cmp<<<2048, 256, 0, stream>>>(B.KR, B.GM, (size_t)MT * 1024, (unsigned*)(p.ws + WS_CTL + 4096));
#endif
    E.res = p.x; E.zout = B.Z;
    GEMM(EPI_OUT, true, B.GR, 2048, B.GM, 1024, 32, B.Wo0t, 1024, 3072);
    k_ln<<<1024, 512, 0, stream>>>(B.Z, p.ln_g, p.ln_b, B.X1, B.X1B);
    GEMM(EPI_IN_O, false, B.X1B, 1024, B.X1B, 1024, 1 << 20, B.W3t, 4096, 1024);
#if !FAST_GEMM
    k_kpart_naive<<<64, 256, 0, stream>>>(B);
#endif
#if DIAG == 2
    k_diag_copy<<<2048, 256, 0, stream>>>((const u32x4*)B.GB, (u32x4*)B.QR, (size_t)MT * 1024 * 2 / 16);
    { Bufs B2 = B; B2.GB = B.QR; k_moba_naive<<<MT * 16 / 4, 256, 0, stream>>>(B2); }
#endif
#if FAST_ATTN
    hipLaunchKernelGGL((k_attn_fast<1>), dim3(256), dim3(512), LDS_MOBA, stream, B);
#else
    k_moba_naive<<<MT * 16 / 4, 256, 0, stream>>>(B);
#endif
#if DIAG == 2
    k_diag_cmp<<<2048, 256, 0, stream>>>(B.QR, B.GB, (size_t)MT * 1024, (unsigned*)(p.ws + WS_CTL + 4096));
#endif
    E.res = B.X1; E.zout = B.Z1;
    GEMM(EPI_OUT, false, B.GB, 1024, B.GB, 1024, 1 << 20, B.Wo1t, 1024, 1024);
    k_ln<<<1024, 512, 0, stream>>>(B.Z1, p.ln_g + DM, p.ln_b + DM, p.out, nullptr);
#if DIAG
    k_diag_out<<<1, 1, 0, stream>>>(p.out, (const unsigned*)(p.ws + WS_CTL + 4096));
#endif
}
```
